# Optimizing an MI355X kernel written in HIP

```python
import math
import jax, jax.numpy as jnp
from jax import lax
import numpy as np

D_MODEL = 1024
BATCH = 4
SEQ = 8192
DEPTH = 4

CTX_LEN = 256
GRID_W = 64
HEAD_DIM = 64
N_HEADS = D_MODEL // HEAD_DIM
N_KV_HEADS = N_HEADS // 4
N_DIFF_HEADS = N_HEADS // 2
D_FF = ((8 * D_MODEL // 3 + 127) // 128) * 128
WINDOW = 128
Q_BLOCK = 128
ROPE_BASE = 10000.0
EPS = 1e-6
NEG_INF = -1e30
ATTN_SCALE = HEAD_DIM ** -0.5
FFN_RESIDUAL = 0.5
N_MIXERS = 3
N_MOD = 9
N_LAYERS_A = (DEPTH + 2) // 3
N_LAYERS_B = (DEPTH + 1) // 3
N_LAYERS_C = DEPTH // 3
MIX_WIDTH = N_HEADS * HEAD_DIM
QKV_GQA = (N_HEADS + 2 * N_KV_HEADS) * HEAD_DIM
QKV_DIFF = 3 * N_DIFF_HEADS * 2 * HEAD_DIM

kernel_name = "hybrid_interleaved_dit_trunk"


def rms_norm(x, g):
    xf = x.astype(jnp.float32)
    y = xf * lax.rsqrt(jnp.mean(xf * xf, axis=-1, keepdims=True) + EPS)
    return (y * g.astype(jnp.float32)).astype(x.dtype)


def modulate(h, shift, scale):
    return h * (1 + scale) + shift


def axial_rope_tables(n_tokens):
    rows = n_tokens // GRID_W
    row = jnp.repeat(jnp.arange(rows), GRID_W)
    col = jnp.tile(jnp.arange(GRID_W), rows)
    n_freq = HEAD_DIM // 4
    inv_freq = ROPE_BASE ** (-jnp.arange(n_freq, dtype=jnp.float32) / n_freq)
    ang = jnp.stack([row, col], axis=-1).astype(jnp.float32)[:, :, None] * inv_freq
    return jnp.cos(ang), jnp.sin(ang)


def apply_axial_rope(x, cos, sin):
    shape = x.shape
    xr = x.astype(jnp.float32).reshape(shape[0], shape[1], -1, 2, 2, HEAD_DIM // 4)
    x1, x2 = xr[..., 0, :], xr[..., 1, :]
    cs, sn = cos[:, None], sin[:, None]
    out = jnp.stack([x1 * cs - x2 * sn, x2 * cs + x1 * sn], axis=-2)
    return out.reshape(shape).astype(x.dtype)


def softmax_with_sink(s, sink):
    if sink is None:
        return jax.nn.softmax(s, axis=-1)
    m = jnp.maximum(jnp.max(s, axis=-1, keepdims=True), sink)
    e = jnp.exp(s - m)
    return e / (jnp.sum(e, axis=-1, keepdims=True) + jnp.exp(sink - m))


def to_query_blocks(q):
    b, t = q.shape[:2]
    return jnp.moveaxis(q.reshape(b, t // Q_BLOCK, Q_BLOCK, *q.shape[2:]), 1, 0)


def from_query_blocks(o):
    o = jnp.moveaxis(o, 0, 1)
    return o.reshape(o.shape[0], -1, *o.shape[3:])


def ffn_half_step(x, mod, k, g, w_in, w_out):
    h = modulate(rms_norm(x, g), mod[:, 3 * k], mod[:, 3 * k + 1])
    a, u = jnp.split(h @ w_in, 2, axis=-1)
    return x + FFN_RESIDUAL * mod[:, 3 * k + 2] * ((jax.nn.silu(a) * u) @ w_out)


def gqa_project(h, w_qkv, qk_g):
    b, t, _ = h.shape
    q, k, v = jnp.split(h @ w_qkv, [N_HEADS * HEAD_DIM, (N_HEADS + N_KV_HEADS) * HEAD_DIM], axis=-1)
    q = rms_norm(q.reshape(b, t, N_HEADS, HEAD_DIM), qk_g[0])
    k = rms_norm(k.reshape(b, t, N_KV_HEADS, HEAD_DIM), qk_g[1])
    return q, k, v.reshape(b, t, N_KV_HEADS, HEAD_DIM)


def full_gqa_attention(q, k, v, sink=None):
    b, t, h, d = q.shape
    kvh = k.shape[2]
    g = h // kvh
    qb = to_query_blocks(q.reshape(b, t, kvh, g, d))
    sink_f = None if sink is None else sink.astype(jnp.float32).reshape(kvh, g, 1, 1)

    def one_block(qi):
        s = jnp.einsum('bqkgd,bskd->bkgqs', qi, k, preferred_element_type=jnp.float32) * ATTN_SCALE
        p = softmax_with_sink(s, sink_f)
        return jnp.einsum('bkgqs,bskd->bqkgd', p.astype(v.dtype), v)

    return from_query_blocks(lax.map(one_block, qb)).reshape(b, t, h * d)


def window_gqa_attention(q, k, v, k_ctx, v_ctx, sink):
    b, n, h, d = q.shape
    kvh = k.shape[2]
    g = h // kvh
    span = Q_BLOCK + 2 * WINDOW
    pad = ((0, 0), (WINDOW, WINDOW), (0, 0), (0, 0))
    k_pad, v_pad = jnp.pad(k, pad), jnp.pad(v, pad)
    qb = to_query_blocks(q.reshape(b, n, kvh, g, d))
    starts = jnp.arange(n // Q_BLOCK) * Q_BLOCK
    rel = jnp.arange(span)[None, :] - WINDOW - jnp.arange(Q_BLOCK)[:, None]
    in_band = jnp.abs(rel) <= WINDOW
    ctx_ok = jnp.ones((Q_BLOCK, k_ctx.shape[1]), dtype=bool)
    sink_f = sink.astype(jnp.float32).reshape(kvh, g, 1, 1)

    def one_block(args):
        qi, start = args
        kpos = start - WINDOW + jnp.arange(span)
        valid = jnp.concatenate([ctx_ok, in_band & ((kpos >= 0) & (kpos < n))[None, :]], axis=-1)
        kk = jnp.concatenate([k_ctx, lax.dynamic_slice_in_dim(k_pad, start, span, axis=1)], axis=1)
        vv = jnp.concatenate([v_ctx, lax.dynamic_slice_in_dim(v_pad, start, span, axis=1)], axis=1)
        s = jnp.einsum('bqkgd,bskd->bkgqs', qi, kk, preferred_element_type=jnp.float32) * ATTN_SCALE
        p = softmax_with_sink(jnp.where(valid, s, NEG_INF), sink_f)
        return jnp.einsum('bkgqs,bskd->bqkgd', p.astype(vv.dtype), vv)

    return from_query_blocks(lax.map(one_block, (qb, starts))).reshape(b, n, h * d)


def dense_gqa_mixer(h_lat, h_ctx, cos, sin, w_qkv, qk_g, with_ctx_out):
    q, k, v = gqa_project(h_lat, w_qkv, qk_g)
    q, k = apply_axial_rope(q, cos, sin), apply_axial_rope(k, cos, sin)
    qc, kc, vc = gqa_project(h_ctx, w_qkv, qk_g)
    o_lat = full_gqa_attention(q, jnp.concatenate([kc, k], axis=1), jnp.concatenate([vc, v], axis=1))
    o_ctx = full_gqa_attention(qc, kc, vc) if with_ctx_out else None
    return o_lat, o_ctx


def window_gqa_mixer(h_lat, h_ctx, cos, sin, w_qkv, qk_g, sink, with_ctx_out):
    q, k, v = gqa_project(h_lat, w_qkv, qk_g)
    q, k = apply_axial_rope(q, cos, sin), apply_axial_rope(k, cos, sin)
    qc, kc, vc = gqa_project(h_ctx, w_qkv, qk_g)
    o_lat = window_gqa_attention(q, k, v, kc, vc, sink)
    o_ctx = full_gqa_attention(qc, kc, vc, sink) if with_ctx_out else None
    return o_lat, o_ctx


def diff_project(h, w_qkv, qk_g):
    b, t, _ = h.shape
    q, k, v = jnp.split(h @ w_qkv, 3, axis=-1)
    q = rms_norm(q.reshape(b, t, N_DIFF_HEADS, 2, HEAD_DIM), qk_g[0])
    k = rms_norm(k.reshape(b, t, N_DIFF_HEADS, 2, HEAD_DIM), qk_g[1])
    return q, k, v.reshape(b, t, N_DIFF_HEADS, 2 * HEAD_DIM)


def diff_attention(q, k, v, lam):
    qb = to_query_blocks(q)

    def one_block(qi):
        s = jnp.einsum('bqhmd,bshmd->bhmqs', qi, k, preferred_element_type=jnp.float32) * ATTN_SCALE
        p = jax.nn.softmax(s, axis=-1)
        w = p[:, :, 0] - lam * p[:, :, 1]
        return jnp.einsum('bhqs,bshe->bqhe', w.astype(v.dtype), v)

    return from_query_blocks(lax.map(one_block, qb))


def diff_mixer(h_lat, h_ctx, cos, sin, w_qkv, qk_g, lam_params, subln_g, layer_idx, with_ctx_out):
    lam_init = 0.8 - 0.6 * math.exp(-0.3 * layer_idx)
    lp = lam_params.astype(jnp.float32)
    lam = jnp.exp(jnp.sum(lp[0] * lp[1])) - jnp.exp(jnp.sum(lp[2] * lp[3])) + lam_init
    q, k, v = diff_project(h_lat, w_qkv, qk_g)
    q, k = apply_axial_rope(q, cos, sin), apply_axial_rope(k, cos, sin)
    qc, kc, vc = diff_project(h_ctx, w_qkv, qk_g)

    def finish(o):
        o = rms_norm(o, subln_g) * (1 - lam_init)
        return o.reshape(o.shape[0], o.shape[1], -1)

    o_lat = finish(diff_attention(q, jnp.concatenate([kc, k], axis=1), jnp.concatenate([vc, v], axis=1), lam))
    o_ctx = finish(diff_attention(qc, kc, vc, lam)) if with_ctx_out else None
    return o_lat, o_ctx


def setup_inputs(seed: int = 0) -> dict:
    key = jax.random.key(seed)
    ks = jax.random.split(key, 20)

    def nrm(k, shape, scale):
        return jax.random.normal(k, shape, jnp.float32) * scale

    return {
        "x": nrm(ks[0], (BATCH, SEQ, D_MODEL), 1.0),
        "c": nrm(ks[1], (BATCH, D_MODEL), 1.0),
        "ctx": nrm(ks[2], (BATCH, CTX_LEN, D_MODEL), 1.0),
        "c_ctx": nrm(ks[3], (D_MODEL,), 1.0),
        "norm_g": 1.0 + nrm(ks[4], (DEPTH, 3, D_MODEL), 0.02),
        "w_ada": nrm(ks[5], (DEPTH, D_MODEL, N_MOD * D_MODEL), 0.5 * D_MODEL ** -0.5),
        "b_ada": nrm(ks[6], (DEPTH, N_MOD * D_MODEL), 0.01),
        "w_ffn_in": nrm(ks[7], (DEPTH, 2, D_MODEL, 2 * D_FF), D_MODEL ** -0.5),
        "w_ffn_out": nrm(ks[8], (DEPTH, 2, D_FF, D_MODEL), D_FF ** -0.5),
        "w_o": nrm(ks[9], (DEPTH, MIX_WIDTH, D_MODEL), MIX_WIDTH ** -0.5),
        "w_qkv_a": nrm(ks[10], (N_LAYERS_A, D_MODEL, QKV_GQA), D_MODEL ** -0.5),
        "qk_norm_a": 1.0 + nrm(ks[11], (N_LAYERS_A, 2, HEAD_DIM), 0.02),
        "w_qkv_b": nrm(ks[12], (N_LAYERS_B, D_MODEL, QKV_GQA), D_MODEL ** -0.5),
        "qk_norm_b": 1.0 + nrm(ks[13], (N_LAYERS_B, 2, HEAD_DIM), 0.02),
        "sink_b": nrm(ks[14], (N_LAYERS_B, N_HEADS), 1.0),
        "w_qkv_c": nrm(ks[15], (N_LAYERS_C, D_MODEL, QKV_DIFF), D_MODEL ** -0.5),
        "qk_norm_c": 1.0 + nrm(ks[16], (N_LAYERS_C, 2, HEAD_DIM), 0.02),
        "diff_lambda": nrm(ks[17], (N_LAYERS_C, 4, HEAD_DIM), 0.1),
        "diff_subln": 1.0 + nrm(ks[18], (N_LAYERS_C, 2 * HEAD_DIM), 0.02),
    }


def reference(x, c, ctx, c_ctx, norm_g, w_ada, b_ada, w_ffn_in, w_ffn_out, w_o,
              w_qkv_a, qk_norm_a, w_qkv_b, qk_norm_b, sink_b,
              w_qkv_c, qk_norm_c, diff_lambda, diff_subln):
    n_lat = x.shape[1]
    cos, sin = axial_rope_tables(n_lat)
    s_lat = jax.nn.silu(c)
    s_ctx = jax.nn.silu(c_ctx)[None]
    for i in range(DEPTH):
        last = i == DEPTH - 1
        m_lat = (s_lat @ w_ada[i] + b_ada[i]).reshape(-1, N_MOD, 1, D_MODEL)
        m_ctx = (s_ctx @ w_ada[i] + b_ada[i]).reshape(-1, N_MOD, 1, D_MODEL)
        x = ffn_half_step(x, m_lat, 0, norm_g[i, 0], w_ffn_in[i, 0], w_ffn_out[i, 0])
        ctx = ffn_half_step(ctx, m_ctx, 0, norm_g[i, 0], w_ffn_in[i, 0], w_ffn_out[i, 0])
        h_lat = modulate(rms_norm(x, norm_g[i, 1]), m_lat[:, 3], m_lat[:, 4])
        h_ctx = modulate(rms_norm(ctx, norm_g[i, 1]), m_ctx[:, 3], m_ctx[:, 4])
        kind, j = i % N_MIXERS, i // N_MIXERS
        if kind == 0:
            o_lat, o_ctx = dense_gqa_mixer(h_lat, h_ctx, cos, sin, w_qkv_a[j], qk_norm_a[j], not last)
        elif kind == 1:
            o_lat, o_ctx = window_gqa_mixer(h_lat, h_ctx, cos, sin, w_qkv_b[j], qk_norm_b[j], sink_b[j], not last)
        else:
            o_lat, o_ctx = diff_mixer(h_lat, h_ctx, cos, sin, w_qkv_c[j], qk_norm_c[j],
                                      diff_lambda[j], diff_subln[j], i, not last)
        x = x + m_lat[:, 5] * (o_lat @ w_o[i])
        x = ffn_half_step(x, m_lat, 2, norm_g[i, 2], w_ffn_in[i, 1], w_ffn_out[i, 1])
        if not last:
            ctx = ctx + m_ctx[:, 5] * (o_ctx @ w_o[i])
            ctx = ffn_half_step(ctx, m_ctx, 2, norm_g[i, 2], w_ffn_in[i, 1], w_ffn_out[i, 1])
    return x
```

```cpp
#include <hip/hip_runtime.h>
#include <hip/hip_cooperative_groups.h>
#include <cstdio>
#include <cstdint>
#include <cmath>
namespace cg = cooperative_groups;
namespace pg8 {
#define PG8_LAS __attribute__((address_space(3)))
typedef unsigned short bf16_t;
typedef short bf16x8 __attribute__((ext_vector_type(8)));
typedef float f32x4 __attribute__((ext_vector_type(4)));
typedef unsigned u32x4 __attribute__((ext_vector_type(4)));
constexpr int BM = 256, BK = 64, HALF = 128, HTB = HALF * BK * 2  , STAGE_BYTES = 8 * HTB, NXCD = 8, WGM = 8;

__host__ __device__ __forceinline__ int lds_byte(int r, int c) { const int st = (r >> 4) * 2 + (c >> 5), rr = r & 15, cc = c & 31, ob = rr * 64 + cc * 2; return st * 1024 + (ob ^ (((ob >> 9) & 1) << 5)); }
__host__ __device__ __forceinline__ void stage_rc(int b, int& R, int& C) { const int st = b / 1024, sb = b % 1024, swz = sb ^ (((sb >> 9) & 1) << 5); R = (st >> 1) * 16 + swz / 64; C = (st & 1) * 32 + (swz % 64) / 2; }
__host__ __device__ __forceinline__ int perm32(int rho) { const int n = rho >> 4, i = rho & 15; return 8 * (i >> 2) + 4 * n + (i & 3); }

struct Unit { int pm, pn, koff, nt; };
struct Gemm { const bf16_t* A; const bf16_t* Bt; int M, N, K; };

struct StaticOrder {
    int nM, nN, nwg, G, c, ntf;
    __host__ __device__ void init(int M, int N, int G_, int c_) { nM = M / BM; nN = N / BM; nwg = nM * nN; G = G_; c = c_; }
    __host__ __device__ bool next(int i, Unit& u) const {
        const long L = (long)i * G + c; if (L >= nwg) return false;
        int wgid = (int)L; { const int q = nwg / NXCD, r = nwg % NXCD, xcd = wgid % NXCD, off = wgid / NXCD; wgid = (xcd < r ? xcd * (q + 1) : r * (q + 1) + (xcd - r) * q) + off; }
        const int nig = WGM * nN, gid = wgid / nig, fm = gid * WGM, gsz = (nM - fm) < WGM ? (nM - fm) : WGM;
        u.pm = fm + ((wgid % nig) % gsz); u.pn = (wgid % nig) / gsz; u.koff = 0; u.nt = ntf; return true;
    }
    __device__ __forceinline__ void a_ready(const Unit&) const {}
    __device__ __forceinline__ void done(const Unit&) const {}
};
struct ResidOrder {
    StaticOrder base; int nkc;
    __host__ __device__ bool next(int i, Unit& u) const {
        const long L = (long)i * base.G + base.c;
        if (L < base.nwg) return base.next(i, u);
        const int j = (int)(L - base.nwg); if (j >= 16 * nkc) return false;
        const int tile = j & 15, kc = j >> 4; u.pm = 128 + (tile >> 2); u.pn = tile & 3; u.koff = kc * 256; u.nt = 4; return true;
    }
    __device__ __forceinline__ void a_ready(const Unit&) const {}
    __device__ __forceinline__ void done(const Unit&) const {}
};

__device__ __forceinline__ unsigned cvt_pk_bf16(float lo, float hi) { unsigned r; asm volatile("v_cvt_pk_bf16_f32 %0, %1, %2" : "=v"(r) : "v"(lo), "v"(hi)); return r; }
typedef float f32x2 __attribute__((ext_vector_type(2)));
__device__ __forceinline__ int dsw_i(int v) { return __builtin_amdgcn_update_dpp(0, v, 0xB1, 0xF, 0xF, true); }
__device__ __forceinline__ float dsw(float v) { return __builtin_bit_cast(float, dsw_i(__builtin_bit_cast(int, v))); }
__device__ __forceinline__ f32x4 dsw4(f32x4 v) { f32x4 r; r.x = dsw(v.x); r.y = dsw(v.y); r.z = dsw(v.z); r.w = dsw(v.w); return r; }
struct EpiSwiglu {
    static constexpr bool PERM = true, AFTER_DRAIN = false;
    bf16_t* O; int ldc; const float* ss  ; const float* bias2  ;
    __device__ __forceinline__ void operator()(const f32x4 (&acc)[2][2][4][2], const Unit& u, int wr, int wc, int fr, int fq) const {
        asm volatile("" : "+v"(fr), "+v"(fq));
        const int row0 = u.pm * BM + wr * 64 + fr, col0 = u.pn * 128 + wc * 32 + 8 * fq;
        const float* bp = bias2 + (u.pm < 128 ? (u.pm >> 5) : 4) * 5632 + u.pn * BM + wc * 32 + 8 * fq;
        f32x4 bv[2][2];
#pragma unroll
        for (int bj = 0; bj < 2; ++bj)
#pragma unroll
            for (int n = 0; n < 2; ++n) bv[bj][n] = *(const f32x4*)(bp + bj * HALF + 4 * n);
        float rs8[2][4];
#pragma unroll
        for (int ai = 0; ai < 2; ++ai)
#pragma unroll
            for (int m = 0; m < 4; ++m) rs8[ai][m] = ss[row0 + ai * HALF + m * 16];
#pragma unroll
        for (int ai = 0; ai < 2; ++ai)
#pragma unroll
            for (int m = 0; m < 4; ++m) {
                bf16_t* rowp = O + (size_t)(row0 + ai * HALF + m * 16) * ldc + col0;
                const float rstd = __builtin_amdgcn_rsqf(rs8[ai][m] * (1.0f / 1024.0f) + 1e-6f);
                float h[8];
#pragma unroll
                for (int n = 0; n < 2; ++n)
#pragma unroll
                    for (int e = 0; e < 4; ++e) { const float a = acc[ai][0][m][n][e] * rstd + bv[0][n][e], uu = acc[ai][1][m][n][e] * rstd + bv[1][n][e];
                        h[n * 4 + e] = a * __builtin_amdgcn_rcpf(1.0f + __builtin_amdgcn_exp2f(-1.4426950408889634f * a)) * uu; }
                u32x4 w; w.x = cvt_pk_bf16(h[0], h[1]); w.y = cvt_pk_bf16(h[2], h[3]); w.z = cvt_pk_bf16(h[4], h[5]); w.w = cvt_pk_bf16(h[6], h[7]);
                *(u32x4*)rowp = w;
            }
    }
};
struct EpiResid {
    static constexpr bool PERM = false, AFTER_DRAIN = false;
    const float* baseL; float* outL; float* part  ; const float* gate  ;
    const float* gnext  ; const float* scnext  ; bf16_t* hb  ; float* ssn  ; float coef; int emit;
    __device__ __forceinline__ void operator()(const f32x4 (&acc)[2][2][4][2], const Unit& u, int wr, int wc, int fr, int fq) const {
        asm volatile("" : "+v"(fr), "+v"(fq));
        const int col0 = u.pn * BM + wc * 32 + 4 * fq;
        if (u.pm >= 128) {
            float* po = part + (size_t)(u.koff >> 8) * 1024 * 1024 + (size_t)(u.pm - 128) * 256 * 1024 + col0;
#pragma unroll
            for (int ai = 0; ai < 2; ++ai)
#pragma unroll
                for (int m = 0; m < 4; ++m) { const size_t off = (size_t)(ai * HALF + wr * 64 + m * 16 + fr) * 1024;
#pragma unroll
                    for (int bj = 0; bj < 2; ++bj)
#pragma unroll
                        for (int n = 0; n < 2; ++n) *(f32x4*)(po + off + bj * HALF + n * 16) = acc[ai][bj][m][n]; }
            return;
        }
        const int slot = u.pm >> 5;
        const float* base = baseL + (size_t)u.pm * 256 * 1024;
        float* out = outL + (size_t)u.pm * 256 * 1024;
        const float* g = gate + slot * 9216 + col0;
        f32x4 gv[2][2], gm[2][2];
        { f32x4 tg[2][2], tn[2][2], ts[2][2];
#pragma unroll
          for (int bj = 0; bj < 2; ++bj)
#pragma unroll
            for (int n = 0; n < 2; ++n) { tg[bj][n] = *(const f32x4*)(g + bj * HALF + n * 16); tn[bj][n] = *(const f32x4*)(gnext + col0 + bj * HALF + n * 16); ts[bj][n] = *(const f32x4*)(scnext + slot * 9216 + col0 + bj * HALF + n * 16); }
          asm volatile("" ::: "memory");
#pragma unroll
          for (int bj = 0; bj < 2; ++bj)
#pragma unroll
            for (int n = 0; n < 2; ++n) { gv[bj][n] = tg[bj][n] * coef; gm[bj][n] = tn[bj][n] * (ts[bj][n] + 1.0f); } }
        asm volatile("" : "+v"(gv[0][0]), "+v"(gv[0][1]), "+v"(gv[1][0]), "+v"(gv[1][1]), "+v"(gm[0][0]), "+v"(gm[0][1]), "+v"(gm[1][0]), "+v"(gm[1][1]));
        bf16_t* hrow = hb + (size_t)u.pm * 256 * 1024; float* ssr = ssn + u.pm * 256;
        const bool odd = (fr & 1) != 0;
        const int colx = col0 - 4 * fq + 4 * fq + (odd ? 16 : 0);
#pragma unroll
        for (int hm = 0; hm < 4; ++hm) {
            const int ai = hm >> 1;
            f32x4 lE[2][2], lO[2][2];
#pragma unroll
            for (int mm = 0; mm < 2; ++mm) { const int m = (hm & 1) * 2 + mm; const size_t offE = (size_t)(ai * HALF + wr * 64 + m * 16 + (fr & ~1)) * 1024 + colx;
#pragma unroll
                for (int bj = 0; bj < 2; ++bj) { lE[mm][bj] = __builtin_nontemporal_load((const f32x4*)(base + offE + bj * HALF)); lO[mm][bj] = __builtin_nontemporal_load((const f32x4*)(base + offE + 1024 + bj * HALF)); } }
#pragma unroll
            for (int mm = 0; mm < 2; ++mm) { const int m = (hm & 1) * 2 + mm; const int r = ai * HALF + wr * 64 + m * 16 + fr; const size_t offE = (size_t)(ai * HALF + wr * 64 + m * 16 + (fr & ~1)) * 1024 + colx;
                float s2 = 0.f;
#pragma unroll
                for (int bj = 0; bj < 2; ++bj) {
                    const f32x4 snd = odd ? lE[mm][bj] : lO[mm][bj]; const f32x4 rcv = dsw4(snd);
                    const f32x4 p0 = odd ? rcv : lE[mm][bj], p1 = odd ? lO[mm][bj] : rcv;
                    const f32x4 x0 = p0 + gv[bj][0] * acc[ai][bj][m][0], x1 = p1 + gv[bj][1] * acc[ai][bj][m][1];
                    const f32x4 snd2 = odd ? x0 : x1; const f32x4 rcv2 = dsw4(snd2);
                    const f32x4 sE = odd ? rcv2 : x0, sO = odd ? x1 : rcv2;
                    __builtin_nontemporal_store(sE, (f32x4*)(out + offE + bj * HALF));
                    __builtin_nontemporal_store(sO, (f32x4*)(out + offE + 1024 + bj * HALF));
                    if (emit) { s2 += (x0[0] * x0[0] + x0[1] * x0[1]) + (x0[2] * x0[2] + x0[3] * x0[3]) + (x1[0] * x1[0] + x1[1] * x1[1]) + (x1[2] * x1[2] + x1[3] * x1[3]);
                        const f32x4 y0 = x0 * gm[bj][0], y1 = x1 * gm[bj][1];
                        typedef unsigned u32x2 __attribute__((ext_vector_type(2)));
                        u32x2 w0, w1; w0.x = cvt_pk_bf16(y0[0], y0[1]); w0.y = cvt_pk_bf16(y0[2], y0[3]); w1.x = cvt_pk_bf16(y1[0], y1[1]); w1.y = cvt_pk_bf16(y1[2], y1[3]);
                        u32x2 ws_ = odd ? w0 : w1, wr_;
                        wr_.x = (unsigned)dsw_i((int)ws_.x); wr_.y = (unsigned)dsw_i((int)ws_.y);
                        const u32x2 hE = odd ? wr_ : w0, hO = odd ? w1 : wr_;
                        *(u32x2*)(hrow + offE + bj * HALF) = hE; *(u32x2*)(hrow + offE + 1024 + bj * HALF) = hO; } }
                if (emit) { s2 += __shfl_xor(s2, 16); s2 += __shfl_xor(s2, 32); if (fq == 0) atomicAdd(ssr + r, s2); }
            }
            asm volatile("" ::: "memory");
        }
    }
};
struct EpiQKV {
    static constexpr bool PERM = false, AFTER_DRAIN = false;
    bf16_t *Q, *K, *V; int nk  , kvp  ; const float* gqk  ; const float* rope  ; float qscale; const float* ss; const float* bias2  ; int nb2;
    __device__ __forceinline__ void operator()(const f32x4 (&acc)[2][2][4][2], const Unit& u, int wr, int wc, int fr, int fq) const {
        asm volatile("" : "+v"(fr), "+v"(fq));
        const int pn = u.pn; const int typ = pn < 4 ? 0 : (pn < 4 + nk ? 1 : 2); const int ct = typ == 0 ? pn : (typ == 1 ? pn - 4 : pn - 4 - nk);
        const bool lat = u.pm < 128; const int b = lat ? (u.pm >> 5) : (u.pm - 128); const int t0 = lat ? (u.pm & 31) * 256 : 0;
        const size_t kvrow0 = (size_t)b * 8448 + (lat ? 256 + t0 : 0);
        bf16_t* dst; int pitch;
        if (typ == 0) { dst = Q + (size_t)u.pm * 256 * 1024; pitch = 1024; } else { dst = (typ == 1 ? K : V) + kvrow0 * kvp; pitch = kvp; }
        const int colh = ct * 256 + wc * 64 + 4 * fq;
        f32x4 gg[2][2];
        if (typ != 2) {
            const float* g = gqk + typ * 64 + 4 * fq;
#pragma unroll
            for (int bj = 0; bj < 2; ++bj)
#pragma unroll
                for (int n = 0; n < 2; ++n) gg[bj][n] = *(const f32x4*)(g + bj * 32 + n * 16);
        }
        const float sc = typ == 0 ? qscale : 1.0f;
        float rs8[2][4];
#pragma unroll
        for (int ai = 0; ai < 2; ++ai)
#pragma unroll
            for (int m = 0; m < 4; ++m) rs8[ai][m] = ss[u.pm * BM + ai * HALF + wr * 64 + m * 16 + fr];
        const bool dorope = lat && typ != 2;
        f32x4 rnx[4];
        if (dorope) { const int t = t0 + wr * 64 + fr; const int pr = t >> 6, pc = t & 63;
            rnx[0] = *(const f32x4*)(rope + pr * 16 + 4 * fq); rnx[1] = *(const f32x4*)(rope + 2048 + pr * 16 + 4 * fq); rnx[2] = *(const f32x4*)(rope + pc * 16 + 4 * fq); rnx[3] = *(const f32x4*)(rope + 2048 + pc * 16 + 4 * fq); }
        f32x4 bv[2][2];
        { const float* bp = bias2 + (lat ? (u.pm >> 5) : 4) * nb2 + pn * BM + wc * 32 + 4 * fq;
#pragma unroll
          for (int bj = 0; bj < 2; ++bj)
#pragma unroll
            for (int n = 0; n < 2; ++n) bv[bj][n] = *(const f32x4*)(bp + bj * HALF + n * 16); }
#pragma unroll
        for (int ai = 0; ai < 2; ++ai)
#pragma unroll
            for (int m = 0; m < 4; ++m) {
                const int r = ai * HALF + wr * 64 + m * 16 + fr;
                const float rs = __builtin_amdgcn_rsqf(rs8[ai][m] * (1.0f / 1024.0f) + 1e-6f);
                f32x4 rcur[4];
#pragma unroll
                for (int q4 = 0; q4 < 4; ++q4) rcur[q4] = rnx[q4];
                if (dorope && !(ai == 1 && m == 3)) { const int mn = (m + 1) & 3, an = ai + ((m + 1) >> 2); const int t = t0 + an * HALF + wr * 64 + mn * 16 + fr; const int pr = t >> 6, pc = t & 63;
                    rnx[0] = *(const f32x4*)(rope + pr * 16 + 4 * fq); rnx[1] = *(const f32x4*)(rope + 2048 + pr * 16 + 4 * fq); rnx[2] = *(const f32x4*)(rope + pc * 16 + 4 * fq); rnx[3] = *(const f32x4*)(rope + 2048 + pc * 16 + 4 * fq); }
                f32x4 y[2][2];
#pragma unroll
                for (int bj = 0; bj < 2; ++bj)
#pragma unroll
                    for (int n = 0; n < 2; ++n) y[bj][n] = acc[ai][bj][m][n] * rs + bv[bj][n];
                if (typ != 2) {
                    float ss = 0.f;
#pragma unroll
                    for (int bj = 0; bj < 2; ++bj)
#pragma unroll
                        for (int n = 0; n < 2; ++n) { const f32x4 x = y[bj][n]; ss += (x[0] * x[0] + x[1] * x[1]) + (x[2] * x[2] + x[3] * x[3]); }
                    ss += __shfl_xor(ss, 16); ss += __shfl_xor(ss, 32);
                    const float rstd = __builtin_amdgcn_rsqf(ss * (1.0f / 64.0f) + 1e-6f);
#pragma unroll
                    for (int bj = 0; bj < 2; ++bj)
#pragma unroll
                        for (int n = 0; n < 2; ++n) y[bj][n] = y[bj][n] * rstd * gg[bj][n];
                    if (lat) {
                        const f32x4 c0 = rcur[0], s0 = rcur[1], c1 = rcur[2], s1 = rcur[3];
                        const f32x4 a1 = y[0][0], a2 = y[0][1], b1 = y[1][0], b2 = y[1][1];
                        y[0][0] = a1 * c0 - a2 * s0; y[0][1] = a2 * c0 + a1 * s0;
                        y[1][0] = b1 * c1 - b2 * s1; y[1][1] = b2 * c1 + b1 * s1;
                    }
                }
                const bool odd = (fr & 1) != 0;
                bf16_t* rowpE = dst + (size_t)(r - (fr & 1)) * pitch + colh + (odd ? 16 : 0);
#pragma unroll
                for (int bj = 0; bj < 2; ++bj) { typedef unsigned u32x2 __attribute__((ext_vector_type(2)));
                    const f32x4 v0 = y[bj][0] * sc, v1 = y[bj][1] * sc;
                    u32x2 w0, w1; w0.x = cvt_pk_bf16(v0[0], v0[1]); w0.y = cvt_pk_bf16(v0[2], v0[3]); w1.x = cvt_pk_bf16(v1[0], v1[1]); w1.y = cvt_pk_bf16(v1[2], v1[3]);
                    const u32x2 ws_ = odd ? w0 : w1; u32x2 wr_; wr_.x = (unsigned)dsw_i((int)ws_.x); wr_.y = (unsigned)dsw_i((int)ws_.y);
                    const u32x2 hE = odd ? wr_ : w0, hO = odd ? w1 : wr_;
                    *(u32x2*)(rowpE + bj * 32) = hE; *(u32x2*)(rowpE + pitch + bj * 32) = hO; }
            }
    }
};
template <class Epi, class Sched, bool ALIGN_EPI = false, bool SP2 = false>
__device__ __forceinline__ void gemm_phase(PG8_LAS unsigned char* lds, const Gemm g, const Sched& S, const Epi& E) {
    int tid_ = threadIdx.x; asm volatile("" : "+v"(tid_));
    const int tid = tid_, wid = __builtin_amdgcn_readfirstlane(tid >> 6), lane = tid & 63, wr = wid >> 2, wc = wid & 3, fr = lane & 15, fq = lane >> 4;
    const int K = g.K;
    unsigned voffA[2], voffB[2];
#pragma unroll
    for (int i = 0; i < 2; ++i) { int R, C; stage_rc(tid * 16 + i * 8192, R, C); const int Rb = Epi::PERM ? ((R & ~31) + perm32(R & 31)) : R;
        voffA[i] = (unsigned)(R * K + C) * 2u; voffB[i] = (unsigned)(Rb * K + C) * 2u; }
    const size_t kstep = (size_t)(BK * 2);
    const size_t hstep = (size_t)HALF * K * 2;
    const size_t tstep = 2 * hstep;
    const unsigned ldsw = (unsigned)wid * 1024u;
    const int aoff = lds_byte(wr * 64 + fr, fq * 8), boff = lds_byte(wc * 32 + fr, fq * 8);
#define PG8_SA(b, h) (((b) * 2 + (h)) * HTB)
#define PG8_SB(b, h) ((4 + (b) * 2 + (h)) * HTB)
#define PG8_STAGE(bufoff, gbase, voff) do { _Pragma("unroll") for (int _i = 0; _i < 2; ++_i) \
        __builtin_amdgcn_global_load_lds((const unsigned*)((const char*)(gbase) + (voff)[_i]), (PG8_LAS unsigned*)(lds + (bufoff) + ldsw + _i * 8192), 16, 0, 0); } while (0)
#define PG8_LDA(dst, b, h) do { _Pragma("unroll") for (int m = 0; m < 4; ++m) _Pragma("unroll") for (int k = 0; k < 2; ++k) dst[m][k] = *(const PG8_LAS bf16x8*)(lds + PG8_SA(b, h) + aoff + m * 2048 + k * 1024); } while (0)
#define PG8_LDB(dst, b, h) do { _Pragma("unroll") for (int n = 0; n < 2; ++n) _Pragma("unroll") for (int k = 0; k < 2; ++k) dst[n][k] = *(const PG8_LAS bf16x8*)(lds + PG8_SB(b, h) + boff + n * 2048 + k * 1024); } while (0)
#define PG8_MMA(ai, bj, At, Bt) do { __builtin_amdgcn_s_setprio(1); _Pragma("unroll") for (int m = 0; m < 4; ++m) _Pragma("unroll") for (int n = 0; n < 2; ++n) _Pragma("unroll") for (int k = 0; k < 2; ++k) \
        acc[ai][bj][m][n] = __builtin_amdgcn_mfma_f32_16x16x32_bf16(Bt[n][k], At[m][k], acc[ai][bj][m][n], 0, 0, 0); __builtin_amdgcn_s_setprio(0); } while (0)
#define PG8_WAIT_V(n) asm volatile("s_waitcnt vmcnt(" #n ")" ::: "memory")
#define PG8_WAIT_L(n) asm volatile("s_waitcnt lgkmcnt(" #n ")" ::: "memory")
#define PG8_BAR __builtin_amdgcn_s_barrier()
#define PG8_SCHED __builtin_amdgcn_sched_barrier(0)
    Unit cur, nxt; int ui = 0;
    if (!S.next(0, cur)) return;
    f32x4 acc[2][2][4][2];
#pragma unroll
    for (int a = 0; a < 2; ++a)
#pragma unroll
        for (int b = 0; b < 2; ++b)
#pragma unroll
            for (int m = 0; m < 4; ++m)
#pragma unroll
                for (int n = 0; n < 2; ++n) acc[a][b][m][n] = (f32x4){0.f, 0.f, 0.f, 0.f};
    bf16x8 At[4][2], B0[2][2], B1[2][2];
    const char* cA = (const char*)g.A + (size_t)cur.pm * tstep + (size_t)cur.koff * 2; const char* cB = (const char*)g.Bt + (size_t)cur.pn * tstep + (size_t)cur.koff * 2;
    S.a_ready(cur);
    if constexpr (SP2) {
        PG8_STAGE(PG8_SB(0, 0), cB, voffB); PG8_STAGE(PG8_SB(0, 1), cB + hstep, voffB); PG8_STAGE(PG8_SA(0, 0), cA, voffA); PG8_STAGE(PG8_SA(0, 1), cA + hstep, voffA);
        if (wr == 1) PG8_BAR;
        PG8_WAIT_V(2); PG8_BAR;
        PG8_STAGE(PG8_SB(1, 0), cB + kstep, voffB); PG8_STAGE(PG8_SA(1, 0), cA + kstep, voffA); PG8_STAGE(PG8_SB(1, 1), cB + hstep + kstep, voffB);
        PG8_WAIT_V(6); PG8_BAR;
    } else {
        PG8_STAGE(PG8_SB(0, 0), cB, voffB); PG8_STAGE(PG8_SA(0, 0), cA, voffA); PG8_STAGE(PG8_SB(0, 1), cB + hstep, voffB); PG8_STAGE(PG8_SA(0, 1), cA + hstep, voffA);
        if (wr == 1) PG8_BAR;
        PG8_WAIT_V(4); PG8_BAR;
        PG8_STAGE(PG8_SB(1, 0), cB + kstep, voffB); PG8_STAGE(PG8_SA(1, 0), cA + kstep, voffA); PG8_STAGE(PG8_SB(1, 1), cB + hstep + kstep, voffB);
        PG8_WAIT_V(6); PG8_BAR;
    }
    for (;;) {
        const bool has_next = S.next(ui + 1, nxt);
        const char* nA = has_next ? (const char*)g.A + (size_t)nxt.pm * tstep + (size_t)nxt.koff * 2 : cA; const char* nB = has_next ? (const char*)g.Bt + (size_t)nxt.pn * tstep + (size_t)nxt.koff * 2 : cB;
        const int nt = cur.nt;
        for (int t = 0; t < nt; t += 2) {
            const bool last = (t == nt - 2);
            const char* a1 = cA + (size_t)(t + 1) * kstep;
            const char* a2 = last ? nA : cA + (size_t)(t + 2) * kstep; const char* b2 = last ? nB : cB + (size_t)(t + 2) * kstep;
            const char* a3 = a2 + kstep; const char* b3 = b2 + kstep;
            if (last && has_next) S.a_ready(nxt);
            if constexpr (SP2) {
            PG8_LDB(B0, 0, 0); PG8_LDB(B1, 0, 1); PG8_SCHED; PG8_LDA(At, 0, 0); PG8_STAGE(PG8_SA(1, 1), a1 + hstep, voffA);
            PG8_WAIT_V(8); PG8_WAIT_L(0); PG8_BAR; PG8_MMA(0, 0, At, B0); PG8_MMA(0, 1, At, B1); PG8_BAR; PG8_SCHED;
            PG8_LDA(At, 0, 1); PG8_STAGE(PG8_SB(0, 0), b2, voffB); PG8_STAGE(PG8_SB(0, 1), b2 + hstep, voffB); PG8_STAGE(PG8_SA(0, 0), a2, voffA);
            PG8_WAIT_V(8); PG8_WAIT_L(0); PG8_BAR; PG8_MMA(1, 0, At, B0); PG8_MMA(1, 1, At, B1); PG8_BAR; PG8_SCHED;
            PG8_LDB(B0, 1, 0); PG8_LDB(B1, 1, 1); PG8_SCHED; PG8_LDA(At, 1, 0); PG8_STAGE(PG8_SA(0, 1), a2 + hstep, voffA);
            PG8_WAIT_V(8); PG8_WAIT_L(0); PG8_BAR; PG8_MMA(0, 0, At, B0); PG8_MMA(0, 1, At, B1); PG8_BAR; PG8_SCHED;
            PG8_LDA(At, 1, 1); PG8_STAGE(PG8_SB(1, 0), b3, voffB); PG8_STAGE(PG8_SB(1, 1), b3 + hstep, voffB); PG8_STAGE(PG8_SA(1, 0), a3, voffA);
            PG8_WAIT_V(8); PG8_WAIT_L(0); PG8_BAR; PG8_MMA(1, 0, At, B0); PG8_MMA(1, 1, At, B1); PG8_BAR; PG8_SCHED;
            } else {
            PG8_LDB(B0, 0, 0); PG8_SCHED; PG8_LDA(At, 0, 0); PG8_STAGE(PG8_SA(1, 1), a1 + hstep, voffA);
            PG8_WAIT_L(8); PG8_BAR; PG8_WAIT_L(0); PG8_MMA(0, 0, At, B0); PG8_BAR; PG8_SCHED;
            PG8_LDB(B1, 0, 1); PG8_STAGE(PG8_SB(0, 0), b2, voffB);
            PG8_BAR; PG8_WAIT_L(0); PG8_MMA(0, 1, At, B1); PG8_BAR;
            PG8_LDA(At, 0, 1); PG8_STAGE(PG8_SA(0, 0), a2, voffA);
            PG8_BAR; PG8_WAIT_L(0); PG8_MMA(1, 0, At, B0); PG8_BAR; PG8_SCHED;
            PG8_STAGE(PG8_SB(0, 1), b2 + hstep, voffB);
            PG8_WAIT_V(6); PG8_BAR; PG8_MMA(1, 1, At, B1); PG8_BAR;
            PG8_LDB(B0, 1, 0); PG8_SCHED; PG8_LDA(At, 1, 0); PG8_STAGE(PG8_SA(0, 1), a2 + hstep, voffA);
            PG8_WAIT_L(8); PG8_BAR; PG8_WAIT_L(0); PG8_MMA(0, 0, At, B0); PG8_BAR; PG8_SCHED;
            PG8_LDB(B1, 1, 1); PG8_STAGE(PG8_SB(1, 0), b3, voffB);
            PG8_BAR; PG8_WAIT_L(0); PG8_MMA(0, 1, At, B1); PG8_BAR;
            PG8_LDA(At, 1, 1); PG8_STAGE(PG8_SA(1, 0), a3, voffA);
            PG8_BAR; PG8_WAIT_L(0); PG8_MMA(1, 0, At, B0); PG8_BAR; PG8_SCHED;
            PG8_STAGE(PG8_SB(1, 1), b3 + hstep, voffB);
            PG8_WAIT_V(6); PG8_BAR; PG8_MMA(1, 1, At, B1); PG8_BAR;
            }
        }
        if constexpr (ALIGN_EPI) { if (wr == 0) PG8_BAR; }
        if constexpr (!Epi::AFTER_DRAIN) { E(acc, cur, wr, wc, fr, fq); S.done(cur); }
        if (!has_next) break;
#pragma unroll
        for (int a = 0; a < 2; ++a)
#pragma unroll
            for (int b = 0; b < 2; ++b)
#pragma unroll
                for (int m = 0; m < 4; ++m)
#pragma unroll
                    for (int n = 0; n < 2; ++n) acc[a][b][m][n] = (f32x4){0.f, 0.f, 0.f, 0.f};
        cur = nxt; cA = nA; cB = nB; ++ui;
        if constexpr (ALIGN_EPI) { if (wr == 1) PG8_BAR; }
    }
    PG8_WAIT_V(0);
    if constexpr (!ALIGN_EPI) { if (wr == 0) PG8_BAR; }
    PG8_BAR;
    if constexpr (Epi::AFTER_DRAIN) { E.fused(acc, cur, wr, wc, fr, fq, lds, wid, lane); S.done(cur); }
#undef PG8_SA
#undef PG8_SB
#undef PG8_STAGE
#undef PG8_LDA
#undef PG8_LDB
#undef PG8_MMA
#undef PG8_WAIT_V
#undef PG8_WAIT_L
#undef PG8_BAR
#undef PG8_SCHED
}
}
#include <hip/hip_bf16.h>
#include <cmath>
namespace attn_body {
using bf16=__hip_bfloat16;
using bf16x8=__attribute__((ext_vector_type(8)))short;
using s16x4=__attribute__((ext_vector_type(4)))short;
using f32x16=__attribute__((ext_vector_type(16)))float;
using u32x4=__attribute__((ext_vector_type(4)))unsigned;
constexpr int BATCH=2,NHEAD=16,SEQ=8192,D=64,DM=NHEAD*D;
constexpr int NW=8,QBLK=32,QB=QBLK*NW,KVBLK=64,NQB=SEQ/QB;
constexpr int ATTN_PITCH=DM, ATTN_UNIT_ROWS=QB;
__device__ __forceinline__ int crow(int r,int hi){return (r&3)+8*(r>>2)+4*hi;}
#define SBAR() __builtin_amdgcn_sched_barrier(0)
__device__ __forceinline__ void cmask(f32x16&p0,f32x16&p1,int jb,int qrel,int hi){
  const float NEG=-INFINITY; int kb=64*jb+4*hi;
  #pragma unroll
  for(int r=0;r<16;++r){int kv=kb+(r&3)+8*(r>>2); if(kv>qrel)p0[r]=NEG; if(kv+32>qrel)p1[r]=NEG;}
}

constexpr int NSLOT=3, SLOTB=8192;
constexpr int LDS_K=0, LDS_V=NSLOT*SLOTB, LDS_WS=2*NSLOT*SLOTB, LDS_OST=LDS_WS+NW*64*4, LDS_BYTES=LDS_OST+NW*4096;
constexpr float C2=0.125f*1.4426950408889634f;
__device__ __forceinline__ void glds16(const void*gsrc,unsigned lds_dst){unsigned keep;
  asm volatile("s_mov_b32 %0, m0\n\ts_mov_b32 m0, %2\n\ts_nop 0\n\tglobal_load_lds_dwordx4 %1, off\n\ts_mov_b32 m0, %0":"=&s"(keep):"v"(gsrc),"s"(lds_dst):"memory");}
__device__ __forceinline__ float max3f(float a,float b,float c){float r;asm("v_max3_f32 %0, %1, %2, %3":"=v"(r):"v"(a),"v"(b),"v"(c));return r;}
__device__ __forceinline__ float max2f(float a,float b){float r;asm("v_max_f32_e32 %0, %1, %2":"=v"(r):"v"(a),"v"(b));return r;}
__device__ __forceinline__ float fadd_s(float a,float b){float r;asm("v_add_f32_e32 %0, %1, %2":"=v"(r):"v"(a),"v"(b));return r;}
__device__ __forceinline__ float fsub_s(float a,float b){float r;asm("v_sub_f32_e32 %0, %1, %2":"=v"(r):"v"(a),"v"(b));return r;}
typedef float f32x2_t __attribute__((ext_vector_type(2))); typedef __bf16 bf16x2_t __attribute__((ext_vector_type(2)));
__device__ __forceinline__ unsigned cvtpk_s(float lo,float hi){f32x2_t v={lo,hi};bf16x2_t b=__builtin_convertvector(v,bf16x2_t);return __builtin_bit_cast(unsigned,b);}
#define WAIT_BAR(N) asm volatile("s_waitcnt vmcnt(" #N ") lgkmcnt(0)\n\ts_barrier":::"memory")

__device__ __forceinline__ void qkt(f32x16&p0,f32x16&p1,const char*Kslot,const bf16x8*qr,const f32x16&negm,int r32,int hi){
  const char*kb=Kslot+hi*1024+r32*16;
  #pragma unroll
  for(int d0=0;d0<4;++d0){
    const bf16x8 b0=*reinterpret_cast<const bf16x8*>(kb+d0*2048);
    const bf16x8 b1=*reinterpret_cast<const bf16x8*>(kb+d0*2048+512);
    if(d0==0){p0=__builtin_amdgcn_mfma_f32_32x32x16_bf16(b0,qr[0],negm,0,0,0);p1=__builtin_amdgcn_mfma_f32_32x32x16_bf16(b1,qr[0],negm,0,0,0);}
    else{p0=__builtin_amdgcn_mfma_f32_32x32x16_bf16(b0,qr[d0],p0,0,0,0);p1=__builtin_amdgcn_mfma_f32_32x32x16_bf16(b1,qr[d0],p1,0,0,0);}}
}
typedef __attribute__((address_space(3))) const char* lds_cptr;
typedef short v4i16_t __attribute__((ext_vector_type(4)));
__device__ __forceinline__ void kload8(bf16x8*kf,lds_cptr kp){
  kf[0]=*(const __attribute__((address_space(3))) bf16x8*)(kp);      kf[1]=*(const __attribute__((address_space(3))) bf16x8*)(kp+512);
  kf[2]=*(const __attribute__((address_space(3))) bf16x8*)(kp+2048); kf[3]=*(const __attribute__((address_space(3))) bf16x8*)(kp+2560);
  kf[4]=*(const __attribute__((address_space(3))) bf16x8*)(kp+4096); kf[5]=*(const __attribute__((address_space(3))) bf16x8*)(kp+4608);
  kf[6]=*(const __attribute__((address_space(3))) bf16x8*)(kp+6144); kf[7]=*(const __attribute__((address_space(3))) bf16x8*)(kp+6656);
}
__device__ __forceinline__ void kload2(bf16x8*kf,lds_cptr kp,int j){ kf[2*j]=*(const __attribute__((address_space(3))) bf16x8*)(kp+j*2048); kf[2*j+1]=*(const __attribute__((address_space(3))) bf16x8*)(kp+j*2048+512); }
__device__ __forceinline__ s16x4 vtr(lds_cptr p){ return __builtin_bit_cast(s16x4,__builtin_amdgcn_ds_read_tr16_b64_v4i16((__attribute__((address_space(3))) v4i16_t*)p)); }
__device__ __forceinline__ float rowmax(const f32x16&p0,const f32x16&p1){
  float a=max3f(p0[0],p0[1],p1[0]),b=max3f(p0[2],p0[3],p1[1]);a=max3f(a,p1[2],p1[3]);
  #pragma unroll
  for(int r=4;r<16;r+=4){a=max3f(a,p0[r],p0[r+1]);b=max3f(b,p0[r+2],p0[r+3]);a=max3f(a,p1[r],p1[r+1]);b=max3f(b,p1[r+2],p1[r+3]);}
  const float m=max2f(a,b);
  auto rr=__builtin_amdgcn_permlane32_swap(__float_as_uint(m),__float_as_uint(m),false,false);
  return max2f(__uint_as_float(rr[0]),__uint_as_float(rr[1]));
}
__device__ __forceinline__ void pv(f32x16*o,int vb,bf16x8 pa0,bf16x8 pa1,bf16x8 pa2,bf16x8 pa3){
  #pragma unroll
  for(int d0=0;d0<2;++d0){s16x4 lo[4],hi[4];
    #pragma unroll
    for(int ks=0;ks<4;++ks){
      asm volatile("ds_read_b64_tr_b16 %0,%1 offset:%c2":"=&v"(lo[ks]):"v"(vb),"i"(d0*4096+ks*1024):"memory");
      asm volatile("ds_read_b64_tr_b16 %0,%1 offset:%c2":"=&v"(hi[ks]):"v"(vb),"i"(d0*4096+ks*1024+512):"memory");}
    asm volatile("s_waitcnt lgkmcnt(0)":::"memory");SBAR();
    #define PK(k) (bf16x8){lo[k][0],lo[k][1],lo[k][2],lo[k][3],hi[k][0],hi[k][1],hi[k][2],hi[k][3]}
    o[d0]=__builtin_amdgcn_mfma_f32_32x32x16_bf16(pa0,PK(0),o[d0],0,0,0);
    o[d0]=__builtin_amdgcn_mfma_f32_32x32x16_bf16(pa1,PK(1),o[d0],0,0,0);
    o[d0]=__builtin_amdgcn_mfma_f32_32x32x16_bf16(pa2,PK(2),o[d0],0,0,0);
    o[d0]=__builtin_amdgcn_mfma_f32_32x32x16_bf16(pa3,PK(3),o[d0],0,0,0);
    #undef PK
  }
}

#ifndef ATTN_STORE16
#define ATTN_STORE16(p,v) (*(u32x4*)(p)=(v))
#endif
__device__ __forceinline__ void wmask(f32x16&p0,f32x16&p1,int t,int qrel,int hi,int q0){
  if(t<4)return;
  const float NEG=-INFINITY; const int kb=-128+64*(t-4)+4*hi;
  #pragma unroll
  for(int r=0;r<16;++r){const int kvrel=kb+(r&3)+8*(r>>2); const int d=kvrel-qrel, kv=q0+kvrel;
    const bool ok0=(d>=-128)&&(d<=128)&&(kv>=0)&&(kv<8192);
    const bool ok1=(d+32>=-128)&&(d+32<=128)&&(kv+32>=0)&&(kv+32<8192);
    if(!ok0)p0[r]=NEG; if(!ok1)p1[r]=NEG;}
}
template<int MODE,int THRL> __device__ __forceinline__ void attn_unit(const bf16*Qb,const bf16*__restrict__ Kh,const bf16*__restrict__ Vh,bf16*Ob,const int QP,const int KP,const int VP,const int OP,const int NT,const int q0,const float sinkl2,char*shm){
  int tid_=threadIdx.x; asm volatile("":"+v"(tid_)); const int tid=tid_,lane=tid&63,r32=lane&31,hi=lane>>5; const int wid=__builtin_amdgcn_readfirstlane(tid>>6);
  const bf16*Qw=Qb+(long)(wid*QBLK)*QP;
  const unsigned lds0=(unsigned)(uintptr_t)shm;
  float*wsf=(float*)(shm+LDS_WS)+wid*64;
  const bf16*ksrc=Kh+(long)lane*KP+wid*8;
  const bf16*vsrc=Vh+(long)(16*(wid&3)+(lane>>2))*VP+(wid>>2)*32+(lane&3)*8;
  const unsigned kdst=lds0+LDS_K+wid*1024, vdst=lds0+LDS_V+wid*1024;
  #define TROW(t) (64*(t)+((MODE==1&&(t)>=4)?(q0-128):0))
  #define DMA_K(t,slot) glds16(ksrc+(long)TROW(t)*KP,(unsigned)__builtin_amdgcn_readfirstlane(kdst+(slot)))
  #define DMA_V(t,slot) glds16(vsrc+(long)TROW(t)*VP,(unsigned)__builtin_amdgcn_readfirstlane(vdst+(slot)))
  const int vb0=(int)(lds0+LDS_V)+((lane>>4)&1)*32+(lane&3)*8+(4*hi+((lane&15)>>2))*64;
  const char*Kbase=shm+LDS_K; bf16x8 kf[8];
  const lds_cptr shm3=(lds_cptr)shm; const lds_cptr kp0=shm3+LDS_K+hi*1024+r32*16; const lds_cptr vp0=shm3+LDS_V+((lane>>4)&1)*32+(lane&3)*8+(4*hi+((lane&15)>>2))*64;
  DMA_K(0,0);DMA_V(0,0);DMA_K(1,SLOTB);
  bf16x8 qr[4];
  #pragma unroll
  for(int d0=0;d0<4;++d0)qr[d0]=*reinterpret_cast<const bf16x8*>(&Qw[(long)r32*QP+d0*16+hi*8]);
  float mhat=0.f,l_reg=0.f;f32x16 o[2];o[0]=f32x16{};o[1]=f32x16{};f32x16 negm=f32x16{};asm volatile("":"+v"(negm));
  const int qrel=wid*QBLK+r32;
  #define CMASK(P0,P1,t) do{ if(MODE==1) wmask(P0,P1,(t),qrel,hi,q0); }while(0)
  bool resc=false;
  #define START(P0,P1) do{ const float rm=rowmax(P0,P1); resc=false; \
    { const float dl=rm; mhat=fadd_s(mhat,dl); \
      _Pragma("unroll") for(int r=0;r<16;++r){P0[r]=fsub_s(P0[r],dl);P1[r]=fsub_s(P1[r],dl);} \
      _Pragma("unroll") for(int r=0;r<16;++r)negm[r]=-mhat; asm volatile("":"+v"(negm)); } \
    _Pragma("unroll") for(int r=0;r<16;++r)P0[r]=__builtin_amdgcn_exp2f(P0[r]); }while(0)
  #define RESC() do{ if(resc){ asm volatile("s_waitcnt lgkmcnt(0)":::"memory"); \
      _Pragma("unroll") for(int d_=0;d_<2;++d_) _Pragma("unroll") for(int r=0;r<16;++r)o[d_][r]*=wsf[crow(r,hi)]; } }while(0)
  f32x16 pA0,pA1,pB0,pB1;
  int sl_prev=0,sl_cur=0,sl_next=SLOTB;
  #define ROT() do{sl_prev=sl_cur;sl_cur=sl_next;sl_next=(sl_next==(NSLOT-1)*SLOTB)?0:sl_next+SLOTB;}while(0)
  DMA_K(2,2*SLOTB);
  WAIT_BAR(3);
  qkt(pA0,pA1,Kbase,qr,negm,r32,hi);asm volatile("s_nop 15\n\ts_nop 7":"+v"(pA0),"+v"(pA1));CMASK(pA0,pA1,0);
  START(pA0,pA1);
  _Pragma("unroll") for(int r=0;r<16;++r)pA1[r]=__builtin_amdgcn_exp2f(pA1[r]);
  WAIT_BAR(0);
  DMA_K(3,0);DMA_V(1,SLOTB);
  ROT();
  kload8(kf,kp0+sl_cur);
  WAIT_BAR(2);
  s16x4 vlo[8],vhi[8]; u32x4 pw0,pw1,pw2,pw3;
  #define PKW(P,B) cvtpk_s(P[B],P[B+1])
  #define PAF(k) __builtin_bit_cast(bf16x8,pw##k)
  #define VFR(i) (bf16x8){vlo[i][0],vlo[i][1],vlo[i][2],vlo[i][3],vhi[i][0],vhi[i][1],vhi[i][2],vhi[i][3]}
  #define PIN(x) asm volatile("":"+v"(x))
  #define MX3(a,b,c) __builtin_fmaxf(__builtin_fmaxf((a),(b)),(c))
  #define GAPA(MF,A0,A1,A2,A3,W0,W1,PW) do{ MF; sacc+=A0; sacc+=A1; sacc+=A2; sacc+=A3; PIN(sacc); W0; W1; PIN(PW); SBAR(); }while(0)
  #define EX(v) __builtin_amdgcn_exp2f(v)
  #define GAPB(MF,X,B) do{ MF; X[B]=EX(X[B]); X[B+1]=EX(X[B+1]); X[B+2]=EX(X[B+2]); X[B+3]=EX(X[B+3]); PIN(X); SBAR(); }while(0)
  #define VRD(i) do{ vlo[i]=vtr(vp_+(((i)>>2)*4096+((i)&3)*1024)); vhi[i]=vtr(vp_+(((i)>>2)*4096+((i)&3)*1024+512)); }while(0)
  #define KRD(G,j) do{ if(G){ kload2(kf,kp0+sl_next,j); SBAR(); } }while(0)
  #define STEP(C0,C1,P0,P1,t,GK,GV,GL) do{ SBAR(); \
    const lds_cptr vp_=vp0+sl_prev; \
    VRD(0); SBAR(); float sacc=(P0[0]+P0[1]); \
    GAPA(C0=__builtin_amdgcn_mfma_f32_32x32x16_bf16(kf[0],qr[0],negm,0,0,0), P0[2],P0[3],P0[4],P0[5],     pw0[0]=PKW(P0,0), pw0[1]=PKW(P0,2), pw0); \
    VRD(4); SBAR(); GAPA(C1=__builtin_amdgcn_mfma_f32_32x32x16_bf16(kf[1],qr[0],negm,0,0,0), P0[6],P0[7],P0[8],P0[9],     pw0[2]=PKW(P0,4), pw0[3]=PKW(P0,6), pw0); \
    VRD(1); SBAR(); GAPA(C0=__builtin_amdgcn_mfma_f32_32x32x16_bf16(kf[2],qr[1],C0,0,0,0),   P0[10],P0[11],P0[12],P0[13], pw1[0]=PKW(P0,8), pw1[1]=PKW(P0,10), pw1); \
    VRD(5); SBAR(); GAPA(C1=__builtin_amdgcn_mfma_f32_32x32x16_bf16(kf[3],qr[1],C1,0,0,0),   P0[14],P0[15],P1[0],P1[1],   pw1[2]=PKW(P0,12),pw1[3]=PKW(P0,14), pw1); \
    VRD(2); SBAR(); GAPA(C0=__builtin_amdgcn_mfma_f32_32x32x16_bf16(kf[4],qr[2],C0,0,0,0),   P1[2],P1[3],P1[4],P1[5],     pw2[0]=PKW(P1,0), pw2[1]=PKW(P1,2), pw2); \
    VRD(6); SBAR(); GAPA(C1=__builtin_amdgcn_mfma_f32_32x32x16_bf16(kf[5],qr[2],C1,0,0,0),   P1[6],P1[7],P1[8],P1[9],     pw2[2]=PKW(P1,4), pw2[3]=PKW(P1,6), pw2); \
    VRD(3); SBAR(); GAPA(C0=__builtin_amdgcn_mfma_f32_32x32x16_bf16(kf[6],qr[3],C0,0,0,0),   P1[10],P1[11],P1[12],P1[13], pw3[0]=PKW(P1,8), pw3[1]=PKW(P1,10), pw3); \
    VRD(7); SBAR(); GAPA(C1=__builtin_amdgcn_mfma_f32_32x32x16_bf16(kf[7],qr[3],C1,0,0,0),   P1[14],P1[15],0.f,0.f,       pw3[2]=PKW(P1,12),pw3[3]=PKW(P1,14), pw3); \
    l_reg+=sacc; \
    if(GK){DMA_K((t)+3,sl_cur);} if(GV){DMA_V((t)+1,sl_next);} \
    CMASK(C0,C1,t); \
    { float a=MX3(C0[0],C0[1],C1[0]),b=MX3(C0[2],C0[3],C1[1]); a=MX3(a,C1[2],C1[3]); \
      _Pragma("unroll") for(int r=4;r<16;r+=4){a=MX3(a,C0[r],C0[r+1]);b=MX3(b,C0[r+2],C0[r+3]);a=MX3(a,C1[r],C1[r+1]);b=MX3(b,C1[r+2],C1[r+3]);} \
      float rm=__builtin_fmaxf(a,b); { auto rr=__builtin_amdgcn_permlane32_swap(__float_as_uint(rm),__float_as_uint(rm),false,false); rm=__builtin_fmaxf(__uint_as_float(rr[0]),__uint_as_float(rr[1])); } \
      resc=false; \
      if(__builtin_expect(__any(rm>(float)THRL),0)){ const float dl=__builtin_fmaxf(rm,0.f); mhat+=dl; \
        _Pragma("unroll") for(int r=0;r<16;++r){C0[r]-=dl;C1[r]-=dl;} \
        _Pragma("unroll") for(int r=0;r<16;++r)negm[r]=-mhat; asm volatile("":"+v"(negm)); \
        const float f=__builtin_amdgcn_exp2f(-dl); l_reg*=f; if(hi==0)wsf[r32]=f; resc=true; } } \
    SBAR(); \
    GAPB(o[0]=__builtin_amdgcn_mfma_f32_32x32x16_bf16(PAF(0),VFR(0),o[0],0,0,0), C0,0); \
    GAPB(o[1]=__builtin_amdgcn_mfma_f32_32x32x16_bf16(PAF(0),VFR(4),o[1],0,0,0), C0,4); \
    KRD(GL,0); GAPB(o[0]=__builtin_amdgcn_mfma_f32_32x32x16_bf16(PAF(1),VFR(1),o[0],0,0,0), C0,8); \
    KRD(GL,1); GAPB(o[1]=__builtin_amdgcn_mfma_f32_32x32x16_bf16(PAF(1),VFR(5),o[1],0,0,0), C0,12); \
    KRD(GL,2); GAPB(o[0]=__builtin_amdgcn_mfma_f32_32x32x16_bf16(PAF(2),VFR(2),o[0],0,0,0), C1,0); \
    KRD(GL,3); GAPB(o[1]=__builtin_amdgcn_mfma_f32_32x32x16_bf16(PAF(2),VFR(6),o[1],0,0,0), C1,4); \
    GAPB(o[0]=__builtin_amdgcn_mfma_f32_32x32x16_bf16(PAF(3),VFR(3),o[0],0,0,0), C1,8); \
    GAPB(o[1]=__builtin_amdgcn_mfma_f32_32x32x16_bf16(PAF(3),VFR(7),o[1],0,0,0), C1,12); \
    }while(0)
  int t=1;
  for(;t+5<NT;t+=2){
    STEP(pB0,pB1,pA0,pA1,t,true,true,true);     WAIT_BAR(2); RESC(); ROT();
    STEP(pA0,pA1,pB0,pB1,t+1,true,true,true);   WAIT_BAR(2); RESC(); ROT();
  }
  #define ENDW(tt) do{ if((tt)+3<NT){WAIT_BAR(2);} else if((tt)+2<NT){WAIT_BAR(1);} else {WAIT_BAR(0);} }while(0)
  for(;t+1<NT;t+=2){
    STEP(pB0,pB1,pA0,pA1,t,(t+3<NT),(t+1<NT),(t+1<NT));       ENDW(t);   RESC(); ROT();
    STEP(pA0,pA1,pB0,pB1,t+1,(t+4<NT),(t+2<NT),(t+2<NT));     ENDW(t+1); RESC(); ROT();
  }
  STEP(pB0,pB1,pA0,pA1,NT-1,false,false,false); RESC();
  { float sacc=pB0[0]+pB0[1]; _Pragma("unroll") for(int r=2;r<16;++r)sacc+=pB0[r]; _Pragma("unroll") for(int r=0;r<16;++r)sacc+=pB1[r]; l_reg+=sacc;
    pw0=(u32x4){PKW(pB0,0),PKW(pB0,2),PKW(pB0,4),PKW(pB0,6)};pw1=(u32x4){PKW(pB0,8),PKW(pB0,10),PKW(pB0,12),PKW(pB0,14)};pw2=(u32x4){PKW(pB1,0),PKW(pB1,2),PKW(pB1,4),PKW(pB1,6)};pw3=(u32x4){PKW(pB1,8),PKW(pB1,10),PKW(pB1,12),PKW(pB1,14)};
    SBAR(); pv(o,vb0+sl_cur,PAF(0),PAF(1),PAF(2),PAF(3)); }
  #undef PKW
  #undef PAF
  #undef VFR
  #undef PIN
  #undef MX3
  #undef GAPA
  #undef GAPB
  #undef EX
  #undef VRD
  #undef KRD
  #undef STEP
  #undef ENDW
  {auto rr=__builtin_amdgcn_permlane32_swap(__float_as_uint(l_reg),__float_as_uint(l_reg),false,false);l_reg=__uint_as_float(rr[0])+__uint_as_float(rr[1]);}
  l_reg+=__builtin_amdgcn_exp2f(sinkl2-mhat);
  if(hi==0)wsf[32+r32]=l_reg;asm volatile("s_waitcnt lgkmcnt(0)":::"memory");
  float rli[16];
  #pragma unroll
  for(int r=0;r<16;++r)rli[r]=__builtin_amdgcn_rcpf(wsf[32+crow(r,hi)]);
  bf16*Ow=Ob+(long)(wid*QBLK)*OP;
  { bf16*stg=(bf16*)(shm+LDS_OST)+wid*2048;
    #pragma unroll
    for(int r=0;r<16;++r){const int orow=crow(r,hi);
      #pragma unroll
      for(int d0=0;d0<2;++d0)stg[orow*64+d0*32+r32]=__float2bfloat16(o[d0][r]*rli[r]);}
    asm volatile("s_waitcnt lgkmcnt(0)":::"memory");
    #pragma unroll
    for(int i=0;i<4;++i){const int row=i*8+(lane>>3),ch=lane&7; const u32x4 v=*(const u32x4*)(stg+row*64+ch*8); ATTN_STORE16(Ow+(long)row*OP+ch*8,v);} }
  asm volatile("s_waitcnt lgkmcnt(0)\n\ts_barrier":::"memory");
  #undef DMA_K
  #undef TROW
  #undef DMA_V
  #undef CMASK
  #undef START
  #undef RESC
  #undef ROT
}
template<int THRL> __device__ __forceinline__ void attn_unit128(const bf16*Qb,const bf16*__restrict__ Kh,const bf16*__restrict__ Vh,bf16*Ob,const int QP,const int KP,const int VP,const int OP,const int NT,char*shm){
  int tid_=threadIdx.x; asm volatile("":"+v"(tid_)); const int tid=tid_,lane=tid&63,r32=lane&31,hi=lane>>5; const int wid=__builtin_amdgcn_readfirstlane(tid>>6);
  constexpr int L_K=0, L_V=3*8192, L_WS=L_V+3*16384, L_OST=L_WS+NW*64*4;
  const bf16*Qw=Qb+(long)(wid*QBLK)*QP;
  const unsigned lds0=(unsigned)(uintptr_t)shm;
  float*wsf=(float*)(shm+L_WS)+wid*64;
  const bf16*ksrc=Kh+(long)lane*KP+wid*8;
  const bf16*vsrc=Vh+(long)(16*(wid&3)+(lane>>2))*VP+(wid>>2)*32+(lane&3)*8;
  const unsigned kdst=lds0+L_K+wid*1024, vdst=lds0+L_V+wid*1024;
  #define DK(t,slot) glds16(ksrc+(long)(64*(t))*KP,(unsigned)__builtin_amdgcn_readfirstlane(kdst+(slot)))
  #define DV(t,slot) do{ glds16(vsrc+(long)(64*(t))*VP,(unsigned)__builtin_amdgcn_readfirstlane(vdst+2*(slot))); glds16(vsrc+(long)(64*(t))*VP+64,(unsigned)__builtin_amdgcn_readfirstlane(vdst+2*(slot)+8192)); }while(0)
  const lds_cptr shm3=(lds_cptr)shm; const lds_cptr kp0=shm3+L_K+hi*1024+r32*16; const lds_cptr vp0=shm3+L_V+((lane>>4)&1)*32+(lane&3)*8+(4*hi+((lane&15)>>2))*64;
  bf16x8 kf[8];
  DK(0,0);DV(0,0);DK(1,SLOTB);
  bf16x8 qr[4];
  #pragma unroll
  for(int d0=0;d0<4;++d0)qr[d0]=*reinterpret_cast<const bf16x8*>(&Qw[(long)r32*QP+d0*16+hi*8]);
  float mhat=0.f,l_reg=0.f;f32x16 o[4];o[0]=f32x16{};o[1]=f32x16{};o[2]=f32x16{};o[3]=f32x16{};f32x16 negm=f32x16{};asm volatile("":"+v"(negm));
  bool resc=false;
  int sl_prev=0,sl_cur=0,sl_next=SLOTB;
  #define ROT() do{sl_prev=sl_cur;sl_cur=sl_next;sl_next=(sl_next==(NSLOT-1)*SLOTB)?0:sl_next+SLOTB;}while(0)
  #define RESC4() do{ if(resc){ asm volatile("s_waitcnt lgkmcnt(0)":::"memory"); \
      _Pragma("unroll") for(int r=0;r<16;++r){ const float f_=wsf[crow(r,hi)]; o[0][r]*=f_; o[1][r]*=f_; o[2][r]*=f_; o[3][r]*=f_; } } }while(0)
  #define MX3(a,b,c) __builtin_fmaxf(__builtin_fmaxf((a),(b)),(c))
  #define PKW(P,B) cvtpk_s(P[B],P[B+1])
  #define PAF(k) __builtin_bit_cast(bf16x8,pw##k)
  #define FRG(lo,hi_) (bf16x8){lo[0],lo[1],lo[2],lo[3],hi_[0],hi_[1],hi_[2],hi_[3]}
  #define ROWMAX(rm) do{ float a=MX3(c0[0],c0[1],c1[0]),b=MX3(c0[2],c0[3],c1[1]); a=MX3(a,c1[2],c1[3]); \
      _Pragma("unroll") for(int r=4;r<16;r+=4){a=MX3(a,c0[r],c0[r+1]);b=MX3(b,c0[r+2],c0[r+3]);a=MX3(a,c1[r],c1[r+1]);b=MX3(b,c1[r+2],c1[r+3]);} \
      rm=__builtin_fmaxf(a,b); { auto rr=__builtin_amdgcn_permlane32_swap(__float_as_uint(rm),__float_as_uint(rm),false,false); rm=__builtin_fmaxf(__uint_as_float(rr[0]),__uint_as_float(rr[1])); } }while(0)
  #define POST() do{ float s_=(c0[0]+c0[1]); _Pragma("unroll") for(int r=2;r<16;++r)s_+=c0[r]; _Pragma("unroll") for(int r=0;r<16;++r)s_+=c1[r]; l_reg+=s_; \
      pw0=(u32x4){PKW(c0,0),PKW(c0,2),PKW(c0,4),PKW(c0,6)};pw1=(u32x4){PKW(c0,8),PKW(c0,10),PKW(c0,12),PKW(c0,14)};pw2=(u32x4){PKW(c1,0),PKW(c1,2),PKW(c1,4),PKW(c1,6)};pw3=(u32x4){PKW(c1,8),PKW(c1,10),PKW(c1,12),PKW(c1,14)}; }while(0)
  u32x4 pw0,pw1,pw2,pw3; f32x16 c0,c1;
  DK(2,2*SLOTB);
  WAIT_BAR(4);
  qkt(c0,c1,shm+L_K,qr,negm,r32,hi);
  { float rm; ROWMAX(rm); mhat=rm;
    #pragma unroll
    for(int r=0;r<16;++r){c0[r]=__builtin_amdgcn_exp2f(c0[r]-rm);c1[r]=__builtin_amdgcn_exp2f(c1[r]-rm);}
    #pragma unroll
    for(int r=0;r<16;++r)negm[r]=-mhat;
    asm volatile("":"+v"(negm)); }
  POST();
  WAIT_BAR(0);
  DK(3,0);DV(1,SLOTB);
  ROT();
  kload8(kf,kp0+sl_cur);
  WAIT_BAR(3);
  const bool late_=(wid>=4);
  for(int t=1;t<NT;++t){
    const bool GK=(t+3<NT), GV=(t+1<NT);
    const lds_cptr vp_=vp0+2*sl_prev;
    s16x4 vlo[8],vhi[8];
    #pragma unroll
    for(int i=0;i<8;++i){ const int fi=(i>>1)+4*(i&1);
      vlo[fi]=vtr(vp_+((fi>>2)*4096+(fi&3)*1024)); vhi[fi]=vtr(vp_+((fi>>2)*4096+(fi&3)*1024+512));
      if((i&1)==0){ if(i==0)c0=__builtin_amdgcn_mfma_f32_32x32x16_bf16(kf[0],qr[0],negm,0,0,0); else c0=__builtin_amdgcn_mfma_f32_32x32x16_bf16(kf[i],qr[i>>1],c0,0,0,0); }
      else        { if(i==1)c1=__builtin_amdgcn_mfma_f32_32x32x16_bf16(kf[1],qr[0],negm,0,0,0); else c1=__builtin_amdgcn_mfma_f32_32x32x16_bf16(kf[i],qr[i>>1],c1,0,0,0); } }
    if(GK){DK(t+3,sl_cur);} if(GV){DV(t+1,sl_next);}
    { float rm; ROWMAX(rm); resc=false;
      if(__builtin_expect(__any(rm>(float)THRL),0)){ const float dl=__builtin_fmaxf(rm,0.f); mhat+=dl;
        #pragma unroll
        for(int r=0;r<16;++r){c0[r]-=dl;c1[r]-=dl;}
        #pragma unroll
        for(int r=0;r<16;++r)negm[r]=-mhat;
        asm volatile("":"+v"(negm));
        const float f=__builtin_amdgcn_exp2f(-dl); l_reg*=f; if(hi==0)wsf[r32]=f; resc=true; } }
    SBAR();
    s16x4 wlo[8],whi[8];
    #pragma unroll
    for(int i=0;i<8;++i){ const int fi=(i>>1)+4*(i&1), ks=i>>1;
      if(GV){ if(i>=3&&i<=6) kload2(kf,kp0+sl_next,i-3); }
      const bf16x8 pa=(ks==0)?PAF(0):(ks==1)?PAF(1):(ks==2)?PAF(2):PAF(3);
      if((i&1)==0) o[0]=__builtin_amdgcn_mfma_f32_32x32x16_bf16(pa,FRG(vlo[fi],vhi[fi]),o[0],0,0,0);
      else         o[1]=__builtin_amdgcn_mfma_f32_32x32x16_bf16(pa,FRG(vlo[fi],vhi[fi]),o[1],0,0,0);
      wlo[fi]=vtr(vp_+(8192+(fi>>2)*4096+(fi&3)*1024)); whi[fi]=vtr(vp_+(8192+(fi>>2)*4096+(fi&3)*1024+512));
      c0[2*i]=__builtin_amdgcn_exp2f(c0[2*i]); c0[2*i+1]=__builtin_amdgcn_exp2f(c0[2*i+1]);
      SBAR(); }
    #define PHASE_B2() do{ \
    _Pragma("unroll") \
    for(int i=0;i<8;++i){ const int fi=(i>>1)+4*(i&1), ks=i>>1; \
    const bf16x8 pa=(ks==0)?PAF(0):(ks==1)?PAF(1):(ks==2)?PAF(2):PAF(3); \
    if((i&1)==0) o[2]=__builtin_amdgcn_mfma_f32_32x32x16_bf16(pa,FRG(wlo[fi],whi[fi]),o[2],0,0,0); \
    else         o[3]=__builtin_amdgcn_mfma_f32_32x32x16_bf16(pa,FRG(wlo[fi],whi[fi]),o[3],0,0,0); \
    c1[2*i]=__builtin_amdgcn_exp2f(c1[2*i]); c1[2*i+1]=__builtin_amdgcn_exp2f(c1[2*i+1]); \
    SBAR(); } \
    }while(0)
    if(!late_){ PHASE_B2(); POST(); }
    if(t+1<NT){
      if(t+3<NT){WAIT_BAR(3);} else if(t+2<NT){WAIT_BAR(2);} else {WAIT_BAR(0);}
      if(late_){ PHASE_B2(); POST(); }
      RESC4(); ROT();
    } else { if(late_){ PHASE_B2(); POST(); } RESC4(); }
  }
  { const lds_cptr vp_=vp0+2*sl_cur;
    #pragma unroll
    for(int d0=0;d0<4;++d0){ s16x4 lo[4],hi4[4];
      #pragma unroll
      for(int ks=0;ks<4;++ks){ lo[ks]=vtr(vp_+(d0*4096+ks*1024)); hi4[ks]=vtr(vp_+(d0*4096+ks*1024+512)); }
      o[d0]=__builtin_amdgcn_mfma_f32_32x32x16_bf16(PAF(0),FRG(lo[0],hi4[0]),o[d0],0,0,0);
      o[d0]=__builtin_amdgcn_mfma_f32_32x32x16_bf16(PAF(1),FRG(lo[1],hi4[1]),o[d0],0,0,0);
      o[d0]=__builtin_amdgcn_mfma_f32_32x32x16_bf16(PAF(2),FRG(lo[2],hi4[2]),o[d0],0,0,0);
      o[d0]=__builtin_amdgcn_mfma_f32_32x32x16_bf16(PAF(3),FRG(lo[3],hi4[3]),o[d0],0,0,0); } }
  {auto rr=__builtin_amdgcn_permlane32_swap(__float_as_uint(l_reg),__float_as_uint(l_reg),false,false);l_reg=__uint_as_float(rr[0])+__uint_as_float(rr[1]);}
  if(hi==0)wsf[32+r32]=l_reg;asm volatile("s_waitcnt lgkmcnt(0)":::"memory");
  float rli[16];
  #pragma unroll
  for(int r=0;r<16;++r)rli[r]=__builtin_amdgcn_rcpf(wsf[32+crow(r,hi)]);
  bf16*Ow=Ob+(long)(wid*QBLK)*OP;
  bf16*stg=(bf16*)(shm+L_OST)+wid*2048;
  #pragma unroll
  for(int ps=0;ps<2;++ps){
    #pragma unroll
    for(int r=0;r<16;++r){const int orow=crow(r,hi);
      #pragma unroll
      for(int d0=0;d0<2;++d0)stg[orow*64+d0*32+r32]=__float2bfloat16(o[2*ps+d0][r]*rli[r]);}
    asm volatile("s_waitcnt lgkmcnt(0)":::"memory");
    #pragma unroll
    for(int i=0;i<4;++i){const int row=i*8+(lane>>3),ch=lane&7; const u32x4 v=*(const u32x4*)(stg+row*64+ch*8); ATTN_STORE16(Ow+(long)row*OP+ps*64+ch*8,v);}
    asm volatile("s_waitcnt lgkmcnt(0)":::"memory");
  }
  asm volatile("s_waitcnt lgkmcnt(0)\n\ts_barrier":::"memory");
  #undef DK
  #undef DV
  #undef ROT
  #undef RESC4
  #undef MX3
  #undef PKW
  #undef PAF
  #undef FRG
  #undef ROWMAX
  #undef POST
  #undef PHASE_B2
}
#undef SBAR
#undef WAIT_BAR
}
constexpr int NWAVES = 8;
constexpr int NB = 4, SEQ = 8192, DM = 1024, CTXL = 256, DFF = 2816, DEPTH = 4;
constexpr int ML = NB * SEQ, MC = NB * CTXL, MT = ML + MC;
constexpr int KVB = CTXL + SEQ;
constexpr float EPS = 1e-6f;
constexpr size_t MiB = 1u << 20;
constexpr size_t WS_BAR = 64 * 1024;
constexpr size_t WS_ROPE = 0;
constexpr size_t WS_MOD = 1 * MiB;
constexpr size_t WS_CTXX = 2 * MiB;
constexpr size_t WS_WIN = 8 * MiB;
constexpr size_t WS_WOUT = 96 * MiB;
constexpr size_t WS_WO = 140 * MiB;
constexpr size_t WS_WQKV = 148 * MiB;
constexpr size_t WS_H = 164 * MiB;
constexpr size_t WS_HID = 230 * MiB;
constexpr size_t WS_Q = 230 * MiB;
constexpr size_t WS_K = 296 * MiB;
constexpr size_t WS_V = 363 * MiB;
constexpr size_t WS_O = 430 * MiB;
constexpr size_t WS_PART = 562 * MiB;
constexpr size_t WS_SS = 606 * MiB;
constexpr size_t WS_BIAS2 = 608 * MiB;
constexpr size_t WS_END = 610 * MiB;
constexpr int B2_LAYER = 71680, B2_QKV = 28160, B2_S1 = 43520;
constexpr int LDS_BYTES = 147456;

#define GAS __attribute__((address_space(1)))
#define LAS __attribute__((address_space(3)))
typedef unsigned short bf16;
typedef unsigned v4u __attribute__((ext_vector_type(4)));
typedef float f32x4 __attribute__((ext_vector_type(4)));
#define LDS_WAIT() asm volatile("s_waitcnt lgkmcnt(0)" ::: "memory")
__device__ __forceinline__ unsigned f2bf(float f) { unsigned u = __builtin_bit_cast(unsigned, f); return (u + 0x7fffu + ((u >> 16) & 1u)) >> 16; }
__device__ __forceinline__ unsigned pk2(float lo, float hi) { return f2bf(lo) | (f2bf(hi) << 16); }
__device__ __forceinline__ float bf2f(unsigned short h) { return __builtin_bit_cast(float, (unsigned)h << 16); }
__device__ __forceinline__ float wave_sum(float v) {
#pragma unroll
    for (int o = 1; o < 64; o <<= 1) v += __shfl_xor(v, o);
    return v;
}
__device__ __forceinline__ void transpose_item(const float* W, int K, int N, bf16* WT, int mode, LAS float* scr, int item, int lane) {
    const int nblk = N / 32, kb = item / nblk, nb = item % nblk, k0 = 64 * kb, n0 = 32 * nb;
    int drow = n0;
    if (mode == 1) { const int isu = n0 >= DFF ? 1 : 0; const int j = n0 - isu * DFF; drow = 256 * (j / 128) + isu * 128 + (j % 128); }
    else if (mode == 2) { const int pn = n0 / 256, cn = n0 % 256; drow = 256 * pn + 128 * ((cn % 64) / 32) + 32 * (cn / 64); }
    float tv[32];
#pragma unroll
    for (int i = 0; i < 32; ++i) tv[i] = __builtin_nontemporal_load(W + (size_t)(k0 + 2 * i + (lane >> 5)) * N + n0 + (lane & 31));
#pragma unroll
    for (int i = 0; i < 32; ++i) scr[(2 * i + (lane >> 5)) * 33 + (lane & 31)] = tv[i];
    LDS_WAIT(); asm volatile("" ::: "memory");
    const int c = lane & 7;
#pragma unroll
    for (int j = 0; j < 4; ++j) { const int n = (lane >> 3) + 8 * j; const LAS float* s = scr + (8 * c) * 33 + n;
        v4u o; o.x = pk2(s[0 * 33], s[1 * 33]); o.y = pk2(s[2 * 33], s[3 * 33]); o.z = pk2(s[4 * 33], s[5 * 33]); o.w = pk2(s[6 * 33], s[7 * 33]);
        *(GAS v4u*)(WT + (size_t)(drow + n) * K + k0 + 8 * c) = o; }
    LDS_WAIT(); asm volatile("" ::: "memory");
}

#define XB_TMO      128
#define XB_XCNT(j)  (256  + 64 * (j))
#define XB_XSUB(j)  (1280 + 64 * (j))
#define XB_XGEN(j)  (2304 + 64 * (j))
#define XB_TOP      3328
#define XB_TOPGEN   3392
#define XCD_BAR_WORDS 3456
#define XB_SPIN_CAP (1u << 18)

__device__ __forceinline__ unsigned xb_ld(unsigned* p)              { return __hip_atomic_load(p, __ATOMIC_RELAXED, __HIP_MEMORY_SCOPE_AGENT); }
__device__ __forceinline__ unsigned xb_add(unsigned* p, unsigned v) { return __hip_atomic_fetch_add(p, v, __ATOMIC_RELAXED, __HIP_MEMORY_SCOPE_AGENT); }
__device__ __forceinline__ unsigned xb_xcc_id() { return (unsigned)__builtin_amdgcn_s_getreg((3 << 11) | 20) & 0xFu; }
#define XB_SPIN(cond, bar) do { unsigned _sp = 0; while (cond) { __builtin_amdgcn_s_sleep(1); \
    if ((++_sp & 255u) == 0u) { if (xb_ld(&(bar)[XB_TMO])) break; if (_sp > XB_SPIN_CAP) { atomicAdd(&(bar)[XB_TMO], 1u); break; } } } } while (0)

struct XcdBarrier {
    unsigned* bar; unsigned x;
    volatile LAS unsigned* st;
};

__device__ __forceinline__ XcdBarrier xcd_barrier_post(unsigned* bar, volatile LAS unsigned* st) {
    XcdBarrier b; b.bar = bar; b.x = xb_xcc_id(); b.st = st;
    if (threadIdx.x == 0) (void)xb_add(&bar[XB_XCNT(b.x)], 1u);
    return b;
}
__device__ __forceinline__ void xcd_barrier_complete(unsigned* bar, unsigned x, unsigned& nloc, unsigned& nx) {
    const unsigned G = gridDim.x * gridDim.y * gridDim.z;
    unsigned sum, cnt, mine, sp = 0u;
    for (;;) {
        sum = 0u; cnt = 0u; mine = 0u;
#pragma unroll
        for (unsigned j = 0; j < 16; ++j) { const unsigned c = xb_ld(&bar[XB_XCNT(j)]); sum += c; cnt += (c > 0u) ? 1u : 0u; mine = (j == x) ? c : mine; }
        if (sum == G) break;
        __builtin_amdgcn_s_sleep(1);
        if ((++sp & 255u) == 0u) { if (xb_ld(&bar[XB_TMO])) break; if (sp > XB_SPIN_CAP) { atomicAdd(&bar[XB_TMO], 1u); break; } }
    }
    nloc = mine > 0u ? mine : 1u; nx = cnt > 0u ? cnt : 1u;
}

__device__ __forceinline__ void xcd_barrier(const XcdBarrier& b) {
    asm volatile("s_waitcnt vmcnt(0)" ::: "memory");
    __syncthreads();
    if (threadIdx.x == 0) {
        unsigned* bar = b.bar;
        __builtin_amdgcn_s_waitcnt(0);
        unsigned nloc = b.st[0], nx = b.st[1];
        if (nloc == 0u) { xcd_barrier_complete(bar, b.x, nloc, nx); b.st[0] = nloc; b.st[1] = nx; }
        const unsigned old = xb_add(&bar[XB_XSUB(b.x)], 1u);
        const unsigned gen = old / nloc;
        if (old + 1u == (gen + 1u) * nloc) {
            __builtin_amdgcn_fence(__ATOMIC_RELEASE, "agent");
            asm volatile("s_waitcnt vmcnt(0)" ::: "memory");
            const unsigned og = xb_add(&bar[XB_TOP], 1u);
            const unsigned tg = og / nx;
            if (og + 1u == (tg + 1u) * nx) xb_add(&bar[XB_TOPGEN], 1u);
            else XB_SPIN(xb_ld(&bar[XB_TOPGEN]) == tg, bar);
            __builtin_amdgcn_fence(__ATOMIC_ACQUIRE, "agent");
            xb_add(&bar[XB_XGEN(b.x)], 1u);
            asm volatile("s_waitcnt vmcnt(0)" ::: "memory");
        } else {
            XB_SPIN(xb_ld(&bar[XB_XGEN(b.x)]) == gen, bar);
            __builtin_amdgcn_fence(__ATOMIC_ACQUIRE, "agent");
            asm volatile("s_waitcnt vmcnt(0)" ::: "memory");
        }
    }
    __syncthreads();
}

struct Args {
    const float *x, *c, *ctx, *c_ctx, *norm_g, *w_ada, *b_ada, *w_ffn_in, *w_ffn_out, *w_o, *w_qkv_a, *qk_norm_a, *w_qkv_b, *qk_norm_b, *sink_b, *w_qkv_c, *qk_norm_c, *diff_lambda, *diff_subln;
    float* out; unsigned char* ws;
    float inv_freq[16];
};

__global__ void __launch_bounds__(NWAVES * 64, 2) dit_fwd(Args A) {
    extern __shared__ __attribute__((aligned(16))) unsigned char lds[];
    cg::grid_group grid = cg::this_grid();
    LAS unsigned char* ldsL = (LAS unsigned char*)lds;
    const int tid = threadIdx.x, lane = tid & 63, wave = __builtin_amdgcn_readfirstlane(tid >> 6);
    const int G = gridDim.x, bx = blockIdx.x;
    const int vcu = (G % 8 == 0) ? (bx % 8) * (G / 8) + bx / 8 : bx;
    const int gw = vcu * NWAVES + wave, NGW = G * NWAVES;

    volatile LAS unsigned* MISC = (volatile LAS unsigned*)(ldsL + 131072 + 320);
    if (tid < 32) MISC[tid] = 0u;
    if (bx == 0) { for (int w = tid; w < XCD_BAR_WORDS; w += NWAVES * 64) __hip_atomic_store((unsigned*)(A.ws + WS_BAR) + w, 0u, __ATOMIC_RELAXED, __HIP_MEMORY_SCOPE_AGENT); }
    { f32x4* z = (f32x4*)(A.ws + WS_SS); for (int w = bx * NWAVES * 64 + tid; w < 12 * MT / 4; w += G * NWAVES * 64) z[w] = (f32x4){0.f, 0.f, 0.f, 0.f}; }
    {
        unsigned char* ws = A.ws;
        float* ROPE = (float*)(ws + WS_ROPE); float* MOD = (float*)(ws + WS_MOD);
        bf16 *WIN = (bf16*)(ws + WS_WIN), *WOUT = (bf16*)(ws + WS_WOUT), *WO = (bf16*)(ws + WS_WO), *WQKV = (bf16*)(ws + WS_WQKV);
        LAS float* sv = (LAS float*)(ldsL + 69632);
        LAS float* part = (LAS float*)(ldsL + 90112);
        for (int idx = tid; idx < 5 * 1024; idx += NWAVES * 64) { const int j = idx >> 10, k = idx & 1023; const float v = (j < 4) ? A.c[j * 1024 + k] : A.c_ctx[k]; sv[idx] = v / (1.0f + __expf(-v)); }
        __syncthreads();
        for (int it = bx; it < 4 * 144; it += G) {
            const int layer = it / 144, cgp = it % 144;
            const float* W = A.w_ada + (size_t)layer * 1024 * 9216 + cgp * 64 + lane;
            float a0 = 0.f, a1 = 0.f, a2 = 0.f, a3 = 0.f, a4 = 0.f;
#pragma unroll 32
            for (int kk = 0; kk < 128; ++kk) { const int k = wave * 128 + kk; const float w = W[(size_t)k * 9216];
                a0 += sv[k] * w; a1 += sv[1024 + k] * w; a2 += sv[2048 + k] * w; a3 += sv[3072 + k] * w; a4 += sv[4096 + k] * w; }
            part[(wave * 5 + 0) * 64 + lane] = a0; part[(wave * 5 + 1) * 64 + lane] = a1; part[(wave * 5 + 2) * 64 + lane] = a2; part[(wave * 5 + 3) * 64 + lane] = a3; part[(wave * 5 + 4) * 64 + lane] = a4;
            __syncthreads();
            if (tid < 320) { const int j = tid >> 6, l = tid & 63; float s = A.b_ada[layer * 9216 + cgp * 64 + l];
#pragma unroll
                for (int w = 0; w < 8; ++w) s += part[(w * 5 + j) * 64 + l];
                MOD[(size_t)(layer * 5 + j) * 9216 + cgp * 64 + l] = s; }
            __syncthreads();
        }
        { const int idx = bx * NWAVES * 64 + tid;
          if (idx < 2048) { const int p = idx >> 4, f = idx & 15; const float ang = (float)p * A.inv_freq[f];
              double rev = (double)ang * 0.15915494309189535; rev -= rint(rev); const float r = (float)(rev * 6.283185307179586);
              ROPE[idx] = __cosf(r); ROPE[2048 + idx] = __sinf(r); } }
        LAS float* scr = (LAS float*)(ldsL + wave * 8448);
        constexpr int I_IN = 16 * 176, I_OUT = 44 * 32, I_O = 16 * 32, I_QA = 16 * 48, I_QC = 16 * 96;
        constexpr int NITEMS = 8 * I_IN + 8 * I_OUT + 4 * I_O + 3 * I_QA + I_QC;
        for (int it = gw; it < NITEMS; it += NGW) {
            int r = it;
            if (r < 8 * I_IN) { const int mi = r / I_IN; transpose_item(A.w_ffn_in + (size_t)mi * 1024 * 5632, 1024, 5632, WIN + (size_t)mi * 5632 * 1024, 1, scr, r % I_IN, lane); continue; } r -= 8 * I_IN;
            if (r < 8 * I_OUT) { const int mi = r / I_OUT; transpose_item(A.w_ffn_out + (size_t)mi * 2816 * 1024, 2816, 1024, WOUT + (size_t)mi * 1024 * 2816, 0, scr, r % I_OUT, lane); continue; } r -= 8 * I_OUT;
            if (r < 4 * I_O) { const int mi = r / I_O; transpose_item(A.w_o + (size_t)mi * 1024 * 1024, 1024, 1024, WO + (size_t)mi * 1024 * 1024, 0, scr, r % I_O, lane); continue; } r -= 4 * I_O;
            if (r < I_QA) { transpose_item(A.w_qkv_a, 1024, 1536, WQKV, 2, scr, r, lane); continue; } r -= I_QA;
            if (r < I_QA) { transpose_item(A.w_qkv_b, 1024, 1536, WQKV + (size_t)1536 * 1024, 2, scr, r, lane); continue; } r -= I_QA;
            if (r < I_QC) { transpose_item(A.w_qkv_c, 1024, 3072, WQKV + (size_t)3072 * 1024, 2, scr, r, lane); continue; } r -= I_QC;
            transpose_item(A.w_qkv_a + (size_t)1024 * 1536, 1024, 1536, WQKV + (size_t)6144 * 1024, 2, scr, r, lane);
        }
    }
    grid.sync();
    const XcdBarrier xbar = xcd_barrier_post((unsigned*)(A.ws + WS_BAR), MISC + 8);

    for (int ph = 0; ph < DEPTH * 11; ++ph) {
        const int i = ph / 11, s = ph % 11, kind = i % 3; const bool last = (i == DEPTH - 1);
        int tidp = threadIdx.x; asm volatile("" : "+v"(tidp));
        const int lane = tidp & 63;
        GAS unsigned char* wsg = (GAS unsigned char*)A.ws; asm volatile("" : "+s"(wsg)); unsigned char* ws = (unsigned char*)wsg;
        float* ROPE = (float*)(ws + WS_ROPE); float* MOD = (float*)(ws + WS_MOD); float* CTXX = (float*)(ws + WS_CTXX);
        bf16 *WIN = (bf16*)(ws + WS_WIN), *WOUT = (bf16*)(ws + WS_WOUT), *WO = (bf16*)(ws + WS_WO), *WQKV = (bf16*)(ws + WS_WQKV);
        bf16 *HB = (bf16*)(ws + WS_H), *HID = (bf16*)(ws + WS_HID), *QB = (bf16*)(ws + WS_Q), *KB = (bf16*)(ws + WS_K), *VB = (bf16*)(ws + WS_V), *OB = (bf16*)(ws + WS_O);
        const int Mi = (last && s >= 6) ? ML : MT;
        const float* modL = MOD + (size_t)i * 5 * 9216;
        const float* xinL = (i == 0 && s < 3) ? A.x : A.out; const float* xinC = (i == 0 && s <= 3) ? A.ctx : CTXX;
        float* SSB = (float*)(ws + WS_SS); float* B2 = (float*)(ws + WS_BIAS2) + (size_t)i * B2_LAYER;
        if (s == 0 || s == 3 || s == 8) {
            if (last && s == 8) continue;
            const int k = (s == 0) ? 0 : (s == 3 ? 1 : 2);
            const bool full = (i == 0 && s == 0);
            float* SSq = SSB + (size_t)(i * 3 + k) * MT;
            const GAS f32x4* g4 = (const GAS f32x4*)(A.norm_g + (size_t)(i * 3 + k) * 1024) + lane;
            const int pnk = (s == 0) ? (i > 0 ? 11 : 0) : (s == 3 ? 11 : 4);
            const float pcoef = (s == 8) ? 1.0f : 0.5f;
            const GAS f32x4* pg4 = (const GAS f32x4*)(MOD + (size_t)((s == 0 ? i - 1 : i) * 5 + 4) * 9216 + (s == 0 ? 8 : (s == 3 ? 2 : 5)) * 1024) + lane;
            const GAS f32x4* pp4 = (const GAS f32x4*)(ws + WS_PART) + lane;
            if (full) {
                f32x4 vnx[4];
                { const GAS f32x4* xr0 = (const GAS f32x4*)(gw < ML ? xinL + (size_t)gw * 1024 : xinC + (size_t)(gw - ML) * 1024) + lane;
#pragma unroll
                  for (int j = 0; j < 4; ++j) vnx[j] = xr0[64 * j]; }
                for (int m = gw; m < MT; m += NGW) {
                    const int slot = m < ML ? (m >> 13) : 4;
                    const GAS f32x4* sc4 = (const GAS f32x4*)(modL + slot * 9216 + (3 * k + 1) * 1024) + lane;
                    f32x4 v[4]; float ss = 0.f;
#pragma unroll
                    for (int j = 0; j < 4; ++j) v[j] = vnx[j];
                    { const int mn = m + NGW; if (mn < MT) { const GAS f32x4* xrn = (const GAS f32x4*)(mn < ML ? xinL + (size_t)mn * 1024 : xinC + (size_t)(mn - ML) * 1024) + lane;
#pragma unroll
                        for (int j = 0; j < 4; ++j) vnx[j] = xrn[64 * j]; } }
#pragma unroll
                    for (int j = 0; j < 4; ++j) ss += (v[j].x * v[j].x + v[j].y * v[j].y) + (v[j].z * v[j].z + v[j].w * v[j].w);
                    ss = wave_sum(ss);
                    if (lane == 0) SSq[m] = ss;
                    GAS unsigned long long* o8 = (GAS unsigned long long*)(HB + (size_t)m * 1024) + lane;
#pragma unroll
                    for (int j = 0; j < 4; ++j) { const f32x4 gg = g4[64 * j], sc = sc4[64 * j];
                        const f32x4 y = v[j] * gg * (sc + 1.0f);
                        o8[64 * j] = (unsigned long long)pk2(y.x, y.y) | ((unsigned long long)pk2(y.z, y.w) << 32); }
                }
            }
            for (int m = (full ? MT : ML) + gw; m < MT; m += NGW) {
                const float* xrow = m < ML ? xinL + (size_t)m * 1024 : xinC + (size_t)(m - ML) * 1024;
                const int slot = m < ML ? (m >> 13) : 4;
                const GAS f32x4* sc4 = (const GAS f32x4*)(modL + slot * 9216 + (3 * k + 1) * 1024) + lane;
                const GAS f32x4* xr = (const GAS f32x4*)xrow + lane;
                f32x4 v[4]; float ss = 0.f;
#pragma unroll
                for (int j = 0; j < 4; ++j) v[j] = xr[64 * j];
                if (m >= ML && pnk > 0) {
                    GAS f32x4* xo = (GAS f32x4*)(CTXX + (size_t)(m - ML) * 1024) + lane;
#pragma unroll
                    for (int j = 0; j < 4; ++j) { f32x4 pa[11];
#pragma unroll
                        for (int kc = 0; kc < 11; ++kc) pa[kc] = pp4[(size_t)(kc < pnk ? kc : 0) * 262144 + (size_t)(m - ML) * 256 + 64 * j];
                        f32x4 a = pa[0];
#pragma unroll
                        for (int kc = 1; kc < 11; ++kc) if (kc < pnk) a += pa[kc];
                        v[j] += a * pg4[64 * j] * pcoef; xo[64 * j] = v[j]; }
                }
#pragma unroll
                for (int j = 0; j < 4; ++j) ss += (v[j].x * v[j].x + v[j].y * v[j].y) + (v[j].z * v[j].z + v[j].w * v[j].w);
                ss = wave_sum(ss);
                if (lane == 0) SSq[m] = ss;
                GAS unsigned long long* o8 = (GAS unsigned long long*)(HB + (size_t)m * 1024) + lane;
#pragma unroll
                for (int j = 0; j < 4; ++j) { const f32x4 gg = g4[64 * j], sc = sc4[64 * j];
                    const f32x4 y = v[j] * gg * (sc + 1.0f);
                    o8[64 * j] = (unsigned long long)pk2(y.x, y.y) | ((unsigned long long)pk2(y.z, y.w) << 32); }
            }
            if (full) {
                float* B2all = (float*)(ws + WS_BIAS2);
                constexpr int B2_ROWS = 3 * 12800 + 14336, B2_CHUNK = (B2_ROWS + 2047) / 2048;
                int r = gw * B2_CHUNK; const int rend = (r + B2_CHUNK < B2_ROWS) ? r + B2_CHUNK : B2_ROWS;
                while (r < rend) {
                    const int layer = r < 12800 ? 0 : (r < 25600 ? 1 : (r < 39936 ? 2 : 3)); const int lbase = layer == 0 ? 0 : (layer == 1 ? 12800 : (layer == 2 ? 25600 : 39936));
                    const int Nq = (layer == 2) ? 3072 : 1536; const int rl = r - lbase;
                    const int kk = rl < 5632 ? 0 : (rl < 5632 + Nq ? 1 : 2); const int kbase = kk == 0 ? 0 : (kk == 1 ? 5632 : 5632 + Nq);
                    const int N = (kk == 1) ? Nq : 5632; const int off = kk == 0 ? 0 : (kk == 1 ? B2_QKV : B2_S1);
                    const bf16* Wt = kk == 1 ? WQKV + (size_t)(layer == 0 ? 0 : (layer == 1 ? 1536 : (layer == 2 ? 3072 : 6144))) * 1024 : WIN + (size_t)(layer * 2 + (kk == 2 ? 1 : 0)) * 5632 * 1024;
                    int n = rl - kbase; const int nseg = ((lbase + kbase + N) < rend ? (lbase + kbase + N) : rend) - r;
                    f32x4 shv[5][4];
#pragma unroll
                    for (int slot = 0; slot < 5; ++slot) { const f32x4* sh = (const f32x4*)(MOD + (size_t)(layer * 5 + slot) * 9216 + (3 * kk) * 1024 + lane * 16);
#pragma unroll
                        for (int q4 = 0; q4 < 4; ++q4) shv[slot][q4] = sh[q4]; }
                    for (int j = 0; j < nseg; j += 2) {
                        const bool two = (j + 1 < nseg);
                        const v4u* wpa = (const v4u*)(Wt + (size_t)(n + j) * 1024 + lane * 16); const v4u* wpb = (const v4u*)(Wt + (size_t)(n + j + (two ? 1 : 0)) * 1024 + lane * 16);
                        const v4u a0 = wpa[0], a1 = wpa[1], b0 = wpb[0], b1 = wpb[1];
                        const unsigned wa[8] = {a0.x, a0.y, a0.z, a0.w, a1.x, a1.y, a1.z, a1.w}, wb[8] = {b0.x, b0.y, b0.z, b0.w, b1.x, b1.y, b1.z, b1.w};
                        float da[5], db[5];
#pragma unroll
                        for (int slot = 0; slot < 5; ++slot) { float sa = 0.f, sb = 0.f;
#pragma unroll
                            for (int e = 0; e < 8; ++e) { const float t0 = shv[slot][e >> 1][(e & 1) * 2], t1 = shv[slot][e >> 1][(e & 1) * 2 + 1];
                                sa += t0 * bf2f((unsigned short)(wa[e] & 0xffffu)) + t1 * bf2f((unsigned short)(wa[e] >> 16));
                                sb += t0 * bf2f((unsigned short)(wb[e] & 0xffffu)) + t1 * bf2f((unsigned short)(wb[e] >> 16)); }
                            da[slot] = sa; db[slot] = sb; }
#pragma unroll
                        for (int o = 1; o < 64; o <<= 1) {
#pragma unroll
                            for (int slot = 0; slot < 5; ++slot) { da[slot] += __shfl_xor(da[slot], o); db[slot] += __shfl_xor(db[slot], o); } }
                        if (lane < 5) { const float va = lane == 0 ? da[0] : (lane == 1 ? da[1] : (lane == 2 ? da[2] : (lane == 3 ? da[3] : da[4])));
                            const float vb = lane == 0 ? db[0] : (lane == 1 ? db[1] : (lane == 2 ? db[2] : (lane == 3 ? db[3] : db[4])));
                            float* dst = B2all + (size_t)layer * B2_LAYER + off + lane * N + n + j;
                            dst[0] = va; if (two) dst[1] = vb; }
                    }
                    r += nseg;
                }
            }
        } else if (s == 1 || s == 9) {
            pg8::Gemm g{HB, WIN + (size_t)(i * 2 + (s == 9 ? 1 : 0)) * 5632 * 1024, Mi, 5632, 1024}; pg8::StaticOrder S; S.init(Mi, 5632, G, bx); S.ntf = 16;
            pg8::EpiSwiglu E{HID, DFF, SSB + (size_t)(i * 3 + (s == 9 ? 2 : 0)) * MT, B2 + (s == 9 ? B2_S1 : 0)};
            pg8::gemm_phase<pg8::EpiSwiglu, pg8::StaticOrder, true, true>(ldsL, g, S, E);
        } else if (s == 2 || s == 7 || s == 10) {
            const int k = (s == 2) ? 0 : (s == 7 ? 1 : 2);
            const bf16* Am = (s == 7) ? ((kind == 2) ? QB : OB) : HID;
            const bf16* Wm = (s == 7) ? WO + (size_t)i * 1024 * 1024 : WOUT + (size_t)(i * 2 + (s == 10 ? 1 : 0)) * 1024 * 2816;
            const int Kd = (s == 7) ? 1024 : 2816;
            pg8::Gemm g{Am, Wm, Mi, 1024, Kd}; pg8::ResidOrder S; S.base.init(ML, 1024, G, bx); S.base.ntf = Kd / 64; S.nkc = (Mi == MT) ? Kd / 256 : 0;
            const int qn = i * 3 + k + 1;
            const bool emit = qn < 3 * DEPTH;
            const int qq = emit ? qn : 0;
            pg8::EpiResid E{xinL, A.out, (float*)(ws + WS_PART), modL + (3 * k + 2) * 1024,
                            A.norm_g + (size_t)qq * 1024, MOD + (size_t)(qq / 3) * 5 * 9216 + (3 * (qq % 3) + 1) * 1024, HB, SSB + (size_t)qq * MT, (s == 7) ? 1.0f : 0.5f, emit ? 1 : 0};
            pg8::gemm_phase<pg8::EpiResid, pg8::ResidOrder, true, false>(ldsL, g, S, E);
        } else if (s == 4) {
            const int N = (kind == 2) ? 3072 : 1536;
            const bf16* Wm = WQKV + (size_t)(i == 0 ? 0 : (i == 1 ? 1536 : (i == 2 ? 3072 : 6144))) * 1024;
            const float* gqk = (kind == 0) ? A.qk_norm_a + (i / 3) * 128 : (kind == 1 ? A.qk_norm_b : A.qk_norm_c);
            pg8::Gemm g{HB, Wm, Mi, N, 1024}; pg8::StaticOrder S; S.init(Mi, N, G, bx); S.ntf = 16;
            pg8::EpiQKV E{QB, KB, VB, (kind == 2) ? 4 : 1, (kind == 2) ? 1024 : 256, gqk, ROPE, attn_body::C2, SSB + (size_t)(i * 3 + 1) * MT, B2 + B2_QKV, N};
            pg8::gemm_phase<pg8::EpiQKV, pg8::StaticOrder, true, true>(ldsL, g, S, E);
        } else if (s == 5) {
            using attn_body::attn_unit;
            typedef const attn_body::bf16* cbp; typedef attn_body::bf16* bp;
            const float NINF = -INFINITY;
            if (kind == 1) {
                for (int u = vcu; u < NB * 16 * 32; u += G) { const int qb = u & 31, h = (u >> 5) & 15, b = u >> 9;
                    const size_t qoff = (size_t)(b * SEQ + qb * 256) * 1024 + h * 64, kvoff = (size_t)b * KVB * 256 + (h >> 2) * 64;
                    attn_unit<1, 8>((cbp)QB + qoff, (cbp)KB + kvoff, (cbp)VB + kvoff, (bp)OB + qoff, 1024, 256, 256, 1024, 12, qb * 256, A.sink_b[h] * 1.4426950408889634f, (char*)lds); }
            }
            const int n0 = (kind == 0) ? NB * 16 * 32 : 0;
            const int nctx = (last || kind == 2) ? 0 : NB * 16;
            for (int u = vcu; u < n0 + nctx; u += G) {
                int h, b, row, nt; float sk = NINF;
                if (u < n0) { const int qb = u & 31; h = (u >> 5) & 15; b = u >> 9; row = b * SEQ + qb * 256; nt = (KVB / 64); }
                else { const int uc = u - n0; h = uc & 15; b = uc >> 4; row = ML + b * CTXL; nt = CTXL / 64; if (kind == 1) sk = A.sink_b[h] * 1.4426950408889634f; }
                const size_t qoff = (size_t)row * 1024 + h * 64, koff = (size_t)b * KVB * 256 + (h >> 2) * 64;
                attn_unit<0, 8>((cbp)QB + qoff, (cbp)KB + koff, (cbp)VB + koff, (bp)OB + qoff, 1024, 256, 256, 1024, nt, 0, sk, (char*)lds);
            }
            if (kind == 2) {
                const int n2 = NB * 8 * 2 * 32, nc2 = last ? 0 : NB * 8 * 2;
                for (int u = vcu; u < n2 + nc2; u += G) {
                    int mp, h8, b, row, nt;
                    if (u < n2) { const int qb = u & 31; mp = (u >> 5) & 1; h8 = (u >> 6) & 7; b = u >> 9; row = b * SEQ + qb * 256; nt = (KVB / 64); }
                    else { const int uc = u - n2; mp = uc & 1; h8 = (uc >> 1) & 7; b = uc >> 4; row = ML + b * CTXL; nt = CTXL / 64; }
                    const size_t qoff = (size_t)row * 1024 + h8 * 128 + mp * 64, koff = (size_t)b * KVB * 1024 + h8 * 128 + mp * 64, voff = (size_t)b * KVB * 1024 + h8 * 128;
                    const size_t ooff = (size_t)row * 2048 + mp * 1024 + h8 * 128;
                    attn_body::attn_unit128<8>((cbp)QB + qoff, (cbp)KB + koff, (cbp)VB + voff, (bp)OB + ooff, 1024, 1024, 1024, 2048, nt, (char*)lds);
                }
            }
        } else {
            if (kind != 2) continue;
            const float lam_init = 0.8f - 0.6f * expf(-0.3f * (float)i);
            const float* lp = A.diff_lambda + (size_t)(i / 3) * 256;
            const float lam = expf(wave_sum(lp[lane] * lp[64 + lane])) - expf(wave_sum(lp[128 + lane] * lp[192 + lane])) + lam_init;
            const float* sg = A.diff_subln + (size_t)(i / 3) * 128 + (lane & 7) * 16;
            float gsub[16];
#pragma unroll
            for (int e = 0; e < 16; ++e) gsub[e] = sg[e] * (1.0f - lam_init);
            for (int m = gw; m < Mi; m += NGW) {
                const v4u* p1 = (const v4u*)(OB + (size_t)m * 2048 + lane * 16); const v4u* p2 = (const v4u*)(OB + (size_t)m * 2048 + 1024 + lane * 16);
                const v4u a0 = p1[0], a1 = p1[1], b0 = p2[0], b1 = p2[1];
                const unsigned aw[8] = {a0.x, a0.y, a0.z, a0.w, a1.x, a1.y, a1.z, a1.w}, bw[8] = {b0.x, b0.y, b0.z, b0.w, b1.x, b1.y, b1.z, b1.w};
                float o[16]; float ss = 0.f;
#pragma unroll
                for (int e = 0; e < 8; ++e) { o[2 * e] = bf2f((unsigned short)(aw[e] & 0xffffu)) - lam * bf2f((unsigned short)(bw[e] & 0xffffu));
                    o[2 * e + 1] = bf2f((unsigned short)(aw[e] >> 16)) - lam * bf2f((unsigned short)(bw[e] >> 16)); ss += o[2 * e] * o[2 * e] + o[2 * e + 1] * o[2 * e + 1]; }
                ss += __shfl_xor(ss, 1); ss += __shfl_xor(ss, 2); ss += __shfl_xor(ss, 4);
                const float rstd = 1.0f / sqrtf(ss * (1.0f / 128.0f) + EPS);
                v4u w0, w1;
                w0.x = pk2(o[0] * rstd * gsub[0], o[1] * rstd * gsub[1]); w0.y = pk2(o[2] * rstd * gsub[2], o[3] * rstd * gsub[3]); w0.z = pk2(o[4] * rstd * gsub[4], o[5] * rstd * gsub[5]); w0.w = pk2(o[6] * rstd * gsub[6], o[7] * rstd * gsub[7]);
                w1.x = pk2(o[8] * rstd * gsub[8], o[9] * rstd * gsub[9]); w1.y = pk2(o[10] * rstd * gsub[10], o[11] * rstd * gsub[11]); w1.z = pk2(o[12] * rstd * gsub[12], o[13] * rstd * gsub[13]); w1.w = pk2(o[14] * rstd * gsub[14], o[15] * rstd * gsub[15]);
                v4u* po = (v4u*)(QB + (size_t)m * 1024 + lane * 16); po[0] = w0; po[1] = w1;
            }
        }
        if (ph + 1 < DEPTH * 11) xcd_barrier(xbar);
    }
}

extern "C" void kernel_launch(void* const* d_in, const int* in_sizes, int n_in, void* d_out, int out_size, void* d_ws, size_t ws_size, hipStream_t stream) {
    static int grid = 0;
    if (grid == 0) {
        if (n_in != 19 || out_size != ML * DM || ws_size < WS_END) { fprintf(stderr, "kernel_launch: unexpected problem (n_in %d, out %d, ws %zu; need ws >= %zu)\n", n_in, out_size, ws_size, (size_t)WS_END); grid = -1; return; }
        int dev = 0, cus = 0, per_cu = 0;
        if (hipGetDevice(&dev) != hipSuccess || hipDeviceGetAttribute(&cus, hipDeviceAttributeMultiprocessorCount, dev) != hipSuccess) { grid = -1; return; }
        if (hipFuncSetAttribute((const void*)dit_fwd, hipFuncAttributeMaxDynamicSharedMemorySize, LDS_BYTES) != hipSuccess) { fprintf(stderr, "kernel_launch: hipFuncSetAttribute failed\n"); grid = -1; return; }
        if (hipOccupancyMaxActiveBlocksPerMultiprocessor(&per_cu, (const void*)dit_fwd, NWAVES * 64, LDS_BYTES) != hipSuccess || per_cu < 1) { fprintf(stderr, "kernel_launch: occupancy query says %d blocks/CU\n", per_cu); per_cu = 1; }
        (void)hipGetLastError();
        grid = cus;
    }
    if (grid < 0) return;
    Args a{};
    a.x = (const float*)d_in[0]; a.c = (const float*)d_in[1]; a.ctx = (const float*)d_in[2]; a.c_ctx = (const float*)d_in[3]; a.norm_g = (const float*)d_in[4];
    a.w_ada = (const float*)d_in[5]; a.b_ada = (const float*)d_in[6]; a.w_ffn_in = (const float*)d_in[7]; a.w_ffn_out = (const float*)d_in[8]; a.w_o = (const float*)d_in[9];
    a.w_qkv_a = (const float*)d_in[10]; a.qk_norm_a = (const float*)d_in[11]; a.w_qkv_b = (const float*)d_in[12]; a.qk_norm_b = (const float*)d_in[13]; a.sink_b = (const float*)d_in[14];
    a.w_qkv_c = (const float*)d_in[15]; a.qk_norm_c = (const float*)d_in[16]; a.diff_lambda = (const float*)d_in[17]; a.diff_subln = (const float*)d_in[18];
    a.out = (float*)d_out; a.ws = (unsigned char*)d_ws;
    for (int f = 0; f < 16; ++f) a.inv_freq[f] = powf(10000.0f, -(float)f / 16.0f);
    void* args[] = {&a};
    hipError_t e = hipLaunchCooperativeKernel((const void*)dit_fwd, dim3(grid), dim3(NWAVES * 64), args, LDS_BYTES, stream);
    if (e != hipSuccess) fprintf(stderr, "kernel_launch: cooperative launch failed: %s (grid %d)\n", hipGetErrorString(e), grid);
}
```

```cpp
#include <hip/hip_runtime.h>
#include <hip/hip_cooperative_groups.h>
#include <cstdio>
#include <cstdint>
#include <cmath>
namespace cg = cooperative_groups;
namespace pg8 {
#define PG8_LAS __attribute__((address_space(3)))
typedef unsigned short bf16_t;
typedef short bf16x8 __attribute__((ext_vector_type(8)));
typedef float f32x4 __attribute__((ext_vector_type(4)));
typedef unsigned u32x4 __attribute__((ext_vector_type(4)));
constexpr int BM = 256, BK = 64, HALF = 128, HTB = HALF * BK * 2  , STAGE_BYTES = 8 * HTB, NXCD = 8, WGM = 8;

__host__ __device__ __forceinline__ int lds_byte(int r, int c) { const int st = (r >> 4) * 2 + (c >> 5), rr = r & 15, cc = c & 31, ob = rr * 64 + cc * 2; return st * 1024 + (ob ^ (((ob >> 9) & 1) << 5)); }
__host__ __device__ __forceinline__ void stage_rc(int b, int& R, int& C) { const int st = b / 1024, sb = b % 1024, swz = sb ^ (((sb >> 9) & 1) << 5); R = (st >> 1) * 16 + swz / 64; C = (st & 1) * 32 + (swz % 64) / 2; }
__host__ __device__ __forceinline__ int perm32(int rho) { const int n = rho >> 4, i = rho & 15; return 8 * (i >> 2) + 4 * n + (i & 3); }

struct Unit { int pm, pn, koff, nt; };
struct Gemm { const bf16_t* A; const bf16_t* Bt; int M, N, K; };

struct StaticOrder {
    int nM, nN, nwg, G, c, ntf;
    __host__ __device__ void init(int M, int N, int G_, int c_) { nM = M / BM; nN = N / BM; nwg = nM * nN; G = G_; c = c_; }
    __host__ __device__ bool next(int i, Unit& u) const {
        const long L = (long)i * G + c; if (L >= nwg) return false;
        int wgid = (int)L; { const int q = nwg / NXCD, r = nwg % NXCD, xcd = wgid % NXCD, off = wgid / NXCD; wgid = (xcd < r ? xcd * (q + 1) : r * (q + 1) + (xcd - r) * q) + off; }
        const int nig = WGM * nN, gid = wgid / nig, fm = gid * WGM, gsz = (nM - fm) < WGM ? (nM - fm) : WGM;
        u.pm = fm + ((wgid % nig) % gsz); u.pn = (wgid % nig) / gsz; u.koff = 0; u.nt = ntf; return true;
    }
    __device__ __forceinline__ void a_ready(const Unit&) const {}
    __device__ __forceinline__ void done(const Unit&) const {}
};
struct ResidOrder {
    StaticOrder base; int nkc;
    __host__ __device__ bool next(int i, Unit& u) const {
        const long L = (long)i * base.G + base.c;
        if (L < base.nwg) return base.next(i, u);
        const int j = (int)(L - base.nwg); if (j >= 16 * nkc) return false;
        const int tile = j & 15, kc = j >> 4; u.pm = 128 + (tile >> 2); u.pn = tile & 3; u.koff = kc * 256; u.nt = 4; return true;
    }
    __device__ __forceinline__ void a_ready(const Unit&) const {}
    __device__ __forceinline__ void done(const Unit&) const {}
};

__device__ __forceinline__ unsigned cvt_pk_bf16(float lo, float hi) { unsigned r; asm volatile("v_cvt_pk_bf16_f32 %0, %1, %2" : "=v"(r) : "v"(lo), "v"(hi)); return r; }
typedef float f32x2 __attribute__((ext_vector_type(2)));
__device__ __forceinline__ int dsw_i(int v) { return __builtin_amdgcn_update_dpp(0, v, 0xB1, 0xF, 0xF, true); }
__device__ __forceinline__ float dsw(float v) { return __builtin_bit_cast(float, dsw_i(__builtin_bit_cast(int, v))); }
__device__ __forceinline__ f32x4 dsw4(f32x4 v) { f32x4 r; r.x = dsw(v.x); r.y = dsw(v.y); r.z = dsw(v.z); r.w = dsw(v.w); return r; }
struct EpiSwiglu {
    static constexpr bool PERM = true, AFTER_DRAIN = false;
    bf16_t* O; int ldc; const float* ss  ; const float* bias2  ;
    __device__ __forceinline__ void operator()(const f32x4 (&acc)[2][2][4][2], const Unit& u, int wr, int wc, int fr, int fq) const {
        asm volatile("" : "+v"(fr), "+v"(fq));
        const int row0 = u.pm * BM + wr * 64 + fr, col0 = u.pn * 128 + wc * 32 + 8 * fq;
        const float* bp = bias2 + (u.pm < 128 ? (u.pm >> 5) : 4) * 5632 + u.pn * BM + wc * 32 + 8 * fq;
        f32x4 bv[2][2];
#pragma unroll
        for (int bj = 0; bj < 2; ++bj)
#pragma unroll
            for (int n = 0; n < 2; ++n) bv[bj][n] = *(const f32x4*)(bp + bj * HALF + 4 * n);
        float rs8[2][4];
#pragma unroll
        for (int ai = 0; ai < 2; ++ai)
#pragma unroll
            for (int m = 0; m < 4; ++m) rs8[ai][m] = ss[row0 + ai * HALF + m * 16];
#pragma unroll
        for (int ai = 0; ai < 2; ++ai)
#pragma unroll
            for (int m = 0; m < 4; ++m) {
                bf16_t* rowp = O + (size_t)(row0 + ai * HALF + m * 16) * ldc + col0;
                const float rstd = __builtin_amdgcn_rsqf(rs8[ai][m] * (1.0f / 1024.0f) + 1e-6f);
                float h[8];
#pragma unroll
                for (int n = 0; n < 2; ++n)
#pragma unroll
                    for (int e = 0; e < 4; ++e) { const float a = acc[ai][0][m][n][e] * rstd + bv[0][n][e], uu = acc[ai][1][m][n][e] * rstd + bv[1][n][e];
                        h[n * 4 + e] = a * __builtin_amdgcn_rcpf(1.0f + __builtin_amdgcn_exp2f(-1.4426950408889634f * a)) * uu; }
                u32x4 w; w.x = cvt_pk_bf16(h[0], h[1]); w.y = cvt_pk_bf16(h[2], h[3]); w.z = cvt_pk_bf16(h[4], h[5]); w.w = cvt_pk_bf16(h[6], h[7]);
                *(u32x4*)rowp = w;
            }
    }
};
struct EpiResid {
    static constexpr bool PERM = false, AFTER_DRAIN = false;
    const float* baseL; float* outL; float* part  ; const float* gate  ;
    const float* gnext  ; const float* scnext  ; bf16_t* hb  ; float* ssn  ; float coef; int emit;
    __device__ __forceinline__ void operator()(const f32x4 (&acc)[2][2][4][2], const Unit& u, int wr, int wc, int fr, int fq) const {
        asm volatile("" : "+v"(fr), "+v"(fq));
        const int col0 = u.pn * BM + wc * 32 + 4 * fq;
        if (u.pm >= 128) {
            float* po = part + (size_t)(u.koff >> 8) * 1024 * 1024 + (size_t)(u.pm - 128) * 256 * 1024 + col0;
#pragma unroll
            for (int ai = 0; ai < 2; ++ai)
#pragma unroll
                for (int m = 0; m < 4; ++m) { const size_t off = (size_t)(ai * HALF + wr * 64 + m * 16 + fr) * 1024;
#pragma unroll
                    for (int bj = 0; bj < 2; ++bj)
#pragma unroll
                        for (int n = 0; n < 2; ++n) *(f32x4*)(po + off + bj * HALF + n * 16) = acc[ai][bj][m][n]; }
            return;
        }
        const int slot = u.pm >> 5;
        const float* base = baseL + (size_t)u.pm * 256 * 1024;
        float* out = outL + (size_t)u.pm * 256 * 1024;
        const float* g = gate + slot * 9216 + col0;
        f32x4 gv[2][2], gm[2][2];
        { f32x4 tg[2][2], tn[2][2], ts[2][2];
#pragma unroll
          for (int bj = 0; bj < 2; ++bj)
#pragma unroll
            for (int n = 0; n < 2; ++n) { tg[bj][n] = *(const f32x4*)(g + bj * HALF + n * 16); tn[bj][n] = *(const f32x4*)(gnext + col0 + bj * HALF + n * 16); ts[bj][n] = *(const f32x4*)(scnext + slot * 9216 + col0 + bj * HALF + n * 16); }
          asm volatile("" ::: "memory");
#pragma unroll
          for (int bj = 0; bj < 2; ++bj)
#pragma unroll
            for (int n = 0; n < 2; ++n) { gv[bj][n] = tg[bj][n] * coef; gm[bj][n] = tn[bj][n] * (ts[bj][n] + 1.0f); } }
        asm volatile("" : "+v"(gv[0][0]), "+v"(gv[0][1]), "+v"(gv[1][0]), "+v"(gv[1][1]), "+v"(gm[0][0]), "+v"(gm[0][1]), "+v"(gm[1][0]), "+v"(gm[1][1]));
        bf16_t* hrow = hb + (size_t)u.pm * 256 * 1024; float* ssr = ssn + u.pm * 256;
        const bool odd = (fr & 1) != 0;
        const int colx = col0 - 4 * fq + 4 * fq + (odd ? 16 : 0);
#pragma unroll
        for (int hm = 0; hm < 4; ++hm) {
            const int ai = hm >> 1;
            f32x4 lE[2][2], lO[2][2];
#pragma unroll
            for (int mm = 0; mm < 2; ++mm) { const int m = (hm & 1) * 2 + mm; const size_t offE = (size_t)(ai * HALF + wr * 64 + m * 16 + (fr & ~1)) * 1024 + colx;
#pragma unroll
                for (int bj = 0; bj < 2; ++bj) { lE[mm][bj] = __builtin_nontemporal_load((const f32x4*)(base + offE + bj * HALF)); lO[mm][bj] = __builtin_nontemporal_load((const f32x4*)(base + offE + 1024 + bj * HALF)); } }
#pragma unroll
            for (int mm = 0; mm < 2; ++mm) { const int m = (hm & 1) * 2 + mm; const int r = ai * HALF + wr * 64 + m * 16 + fr; const size_t offE = (size_t)(ai * HALF + wr * 64 + m * 16 + (fr & ~1)) * 1024 + colx;
                float s2 = 0.f;
#pragma unroll
                for (int bj = 0; bj < 2; ++bj) {
                    const f32x4 snd = odd ? lE[mm][bj] : lO[mm][bj]; const f32x4 rcv = dsw4(snd);
                    const f32x4 p0 = odd ? rcv : lE[mm][bj], p1 = odd ? lO[mm][bj] : rcv;
                    const f32x4 x0 = p0 + gv[bj][0] * acc[ai][bj][m][0], x1 = p1 + gv[bj][1] * acc[ai][bj][m][1];
                    const f32x4 snd2 = odd ? x0 : x1; const f32x4 rcv2 = dsw4(snd2);
                    const f32x4 sE = odd ? rcv2 : x0, sO = odd ? x1 : rcv2;
                    __builtin_nontemporal_store(sE, (f32x4*)(out + offE + bj * HALF));
                    __builtin_nontemporal_store(sO, (f32x4*)(out + offE + 1024 + bj * HALF));
                    if (emit) { s2 += (x0[0] * x0[0] + x0[1] * x0[1]) + (x0[2] * x0[2] + x0[3] * x0[3]) + (x1[0] * x1[0] + x1[1] * x1[1]) + (x1[2] * x1[2] + x1[3] * x1[3]);
                        const f32x4 y0 = x0 * gm[bj][0], y1 = x1 * gm[bj][1];
                        typedef unsigned u32x2 __attribute__((ext_vector_type(2)));
                        u32x2 w0, w1; w0.x = cvt_pk_bf16(y0[0], y0[1]); w0.y = cvt_pk_bf16(y0[2], y0[3]); w1.x = cvt_pk_bf16(y1[0], y1[1]); w1.y = cvt_pk_bf16(y1[2], y1[3]);
                        u32x2 ws_ = odd ? w0 : w1, wr_;
                        wr_.x = (unsigned)dsw_i((int)ws_.x); wr_.y = (unsigned)dsw_i((int)ws_.y);
                        const u32x2 hE = odd ? wr_ : w0, hO = odd ? w1 : wr_;
                        *(u32x2*)(hrow + offE + bj * HALF) = hE; *(u32x2*)(hrow + offE + 1024 + bj * HALF) = hO; } }
                if (emit) { s2 += __shfl_xor(s2, 16); s2 += __shfl_xor(s2, 32); if (fq == 0) atomicAdd(ssr + r, s2); }
            }
            asm volatile("" ::: "memory");
        }
    }
};
struct EpiQKV {
    static constexpr bool PERM = false, AFTER_DRAIN = false;
    bf16_t *Q, *K, *V; int nk  , kvp  ; const float* gqk  ; const float* rope  ; float qscale; const float* ss; const float* bias2  ; int nb2;
    __device__ __forceinline__ void operator()(const f32x4 (&acc)[2][2][4][2], const Unit& u, int wr, int wc, int fr, int fq) const {
        asm volatile("" : "+v"(fr), "+v"(fq));
        const int pn = u.pn; const int typ = pn < 4 ? 0 : (pn < 4 + nk ? 1 : 2); const int ct = typ == 0 ? pn : (typ == 1 ? pn - 4 : pn - 4 - nk);
        const bool lat = u.pm < 128; const int b = lat ? (u.pm >> 5) : (u.pm - 128); const int t0 = lat ? (u.pm & 31) * 256 : 0;
        const size_t kvrow0 = (size_t)b * 8448 + (lat ? 256 + t0 : 0);
        bf16_t* dst; int pitch;
        if (typ == 0) { dst = Q + (size_t)u.pm * 256 * 1024; pitch = 1024; } else { dst = (typ == 1 ? K : V) + kvrow0 * kvp; pitch = kvp; }
        const int colh = ct * 256 + wc * 64 + 4 * fq;
        f32x4 gg[2][2];
        if (typ != 2) {
            const float* g = gqk + typ * 64 + 4 * fq;
#pragma unroll
            for (int bj = 0; bj < 2; ++bj)
#pragma unroll
                for (int n = 0; n < 2; ++n) gg[bj][n] = *(const f32x4*)(g + bj * 32 + n * 16);
        }
        const float sc = typ == 0 ? qscale : 1.0f;
        float rs8[2][4];
#pragma unroll
        for (int ai = 0; ai < 2; ++ai)
#pragma unroll
            for (int m = 0; m < 4; ++m) rs8[ai][m] = ss[u.pm * BM + ai * HALF + wr * 64 + m * 16 + fr];
        const bool dorope = lat && typ != 2;
        f32x4 rnx[4];
        if (dorope) { const int t = t0 + wr * 64 + fr; const int pr = t >> 6, pc = t & 63;
            rnx[0] = *(const f32x4*)(rope + pr * 16 + 4 * fq); rnx[1] = *(const f32x4*)(rope + 2048 + pr * 16 + 4 * fq); rnx[2] = *(const f32x4*)(rope + pc * 16 + 4 * fq); rnx[3] = *(const f32x4*)(rope + 2048 + pc * 16 + 4 * fq); }
        f32x4 bv[2][2];
        { const float* bp = bias2 + (lat ? (u.pm >> 5) : 4) * nb2 + pn * BM + wc * 32 + 4 * fq;
#pragma unroll
          for (int bj = 0; bj < 2; ++bj)
#pragma unroll
            for (int n = 0; n < 2; ++n) bv[bj][n] = *(const f32x4*)(bp + bj * HALF + n * 16); }
#pragma unroll
        for (int ai = 0; ai < 2; ++ai)
#pragma unroll
            for (int m = 0; m < 4; ++m) {
                const int r = ai * HALF + wr * 64 + m * 16 + fr;
                const float rs = __builtin_amdgcn_rsqf(rs8[ai][m] * (1.0f / 1024.0f) + 1e-6f);
                f32x4 rcur[4];
#pragma unroll
                for (int q4 = 0; q4 < 4; ++q4) rcur[q4] = rnx[q4];
                if (dorope && !(ai == 1 && m == 3)) { const int mn = (m + 1) & 3, an = ai + ((m + 1) >> 2); const int t = t0 + an * HALF + wr * 64 + mn * 16 + fr; const int pr = t >> 6, pc = t & 63;
                    rnx[0] = *(const f32x4*)(rope + pr * 16 + 4 * fq); rnx[1] = *(const f32x4*)(rope + 2048 + pr * 16 + 4 * fq); rnx[2] = *(const f32x4*)(rope + pc * 16 + 4 * fq); rnx[3] = *(const f32x4*)(rope + 2048 + pc * 16 + 4 * fq); }
                f32x4 y[2][2];
#pragma unroll
                for (int bj = 0; bj < 2; ++bj)
#pragma unroll
                    for (int n = 0; n < 2; ++n) y[bj][n] = acc[ai][bj][m][n] * rs + bv[bj][n];
                if (typ != 2) {
                    float ss = 0.f;
#pragma unroll
                    for (int bj = 0; bj < 2; ++bj)
#pragma unroll
                        for (int n = 0; n < 2; ++n) { const f32x4 x = y[bj][n]; ss += (x[0] * x[0] + x[1] * x[1]) + (x[2] * x[2] + x[3] * x[3]); }
                    ss += __shfl_xor(ss, 16); ss += __shfl_xor(ss, 32);
                    const float rstd = __builtin_amdgcn_rsqf(ss * (1.0f / 64.0f) + 1e-6f);
#pragma unroll
                    for (int bj = 0; bj < 2; ++bj)
#pragma unroll
                        for (int n = 0; n < 2; ++n) y[bj][n] = y[bj][n] * rstd * gg[bj][n];
                    if (lat) {
                        const f32x4 c0 = rcur[0], s0 = rcur[1], c1 = rcur[2], s1 = rcur[3];
                        const f32x4 a1 = y[0][0], a2 = y[0][1], b1 = y[1][0], b2 = y[1][1];
                        y[0][0] = a1 * c0 - a2 * s0; y[0][1] = a2 * c0 + a1 * s0;
                        y[1][0] = b1 * c1 - b2 * s1; y[1][1] = b2 * c1 + b1 * s1;
                    }
                }
                const bool odd = (fr & 1) != 0;
                bf16_t* rowpE = dst + (size_t)(r - (fr & 1)) * pitch + colh + (odd ? 16 : 0);
#pragma unroll
                for (int bj = 0; bj < 2; ++bj) { typedef unsigned u32x2 __attribute__((ext_vector_type(2)));
                    const f32x4 v0 = y[bj][0] * sc, v1 = y[bj][1] * sc;
                    u32x2 w0, w1; w0.x = cvt_pk_bf16(v0[0], v0[1]); w0.y = cvt_pk_bf16(v0[2], v0[3]); w1.x = cvt_pk_bf16(v1[0], v1[1]); w1.y = cvt_pk_bf16(v1[2], v1[3]);
                    const u32x2 ws_ = odd ? w0 : w1; u32x2 wr_; wr_.x = (unsigned)dsw_i((int)ws_.x); wr_.y = (unsigned)dsw_i((int)ws_.y);
                    const u32x2 hE = odd ? wr_ : w0, hO = odd ? w1 : wr_;
                    *(u32x2*)(rowpE + bj * 32) = hE; *(u32x2*)(rowpE + pitch + bj * 32) = hO; }
            }
    }
};
template <class Epi, class Sched, bool ALIGN_EPI = false, bool SP2 = false>
__device__ __forceinline__ void gemm_phase(PG8_LAS unsigned char* lds, const Gemm g, const Sched& S, const Epi& E) {
    int tid_ = threadIdx.x; asm volatile("" : "+v"(tid_));
    const int tid = tid_, wid = __builtin_amdgcn_readfirstlane(tid >> 6), lane = tid & 63, wr = wid >> 2, wc = wid & 3, fr = lane & 15, fq = lane >> 4;
    const int K = g.K;
    unsigned voffA[2], voffB[2];
#pragma unroll
    for (int i = 0; i < 2; ++i) { int R, C; stage_rc(tid * 16 + i * 8192, R, C); const int Rb = Epi::PERM ? ((R & ~31) + perm32(R & 31)) : R;
        voffA[i] = (unsigned)(R * K + C) * 2u; voffB[i] = (unsigned)(Rb * K + C) * 2u; }
    const size_t kstep = (size_t)(BK * 2);
    const size_t hstep = (size_t)HALF * K * 2;
    const size_t tstep = 2 * hstep;
    const unsigned ldsw = (unsigned)wid * 1024u;
    const int aoff = lds_byte(wr * 64 + fr, fq * 8), boff = lds_byte(wc * 32 + fr, fq * 8);
#define PG8_SA(b, h) (((b) * 2 + (h)) * HTB)
#define PG8_SB(b, h) ((4 + (b) * 2 + (h)) * HTB)
#define PG8_STAGE(bufoff, gbase, voff) do { _Pragma("unroll") for (int _i = 0; _i < 2; ++_i) \
        __builtin_amdgcn_global_load_lds((const unsigned*)((const char*)(gbase) + (voff)[_i]), (PG8_LAS unsigned*)(lds + (bufoff) + ldsw + _i * 8192), 16, 0, 0); } while (0)
#define PG8_LDA(dst, b, h) do { _Pragma("unroll") for (int m = 0; m < 4; ++m) _Pragma("unroll") for (int k = 0; k < 2; ++k) dst[m][k] = *(const PG8_LAS bf16x8*)(lds + PG8_SA(b, h) + aoff + m * 2048 + k * 1024); } while (0)
#define PG8_LDB(dst, b, h) do { _Pragma("unroll") for (int n = 0; n < 2; ++n) _Pragma("unroll") for (int k = 0; k < 2; ++k) dst[n][k] = *(const PG8_LAS bf16x8*)(lds + PG8_SB(b, h) + boff + n * 2048 + k * 1024); } while (0)
#define PG8_MMA(ai, bj, At, Bt) do { __builtin_amdgcn_s_setprio(1); _Pragma("unroll") for (int m = 0; m < 4; ++m) _Pragma("unroll") for (int n = 0; n < 2; ++n) _Pragma("unroll") for (int k = 0; k < 2; ++k) \
        acc[ai][bj][m][n] = __builtin_amdgcn_mfma_f32_16x16x32_bf16(Bt[n][k], At[m][k], acc[ai][bj][m][n], 0, 0, 0); __builtin_amdgcn_s_setprio(0); } while (0)
#define PG8_WAIT_V(n) asm volatile("s_waitcnt vmcnt(" #n ")" ::: "memory")
#define PG8_WAIT_L(n) asm volatile("s_waitcnt lgkmcnt(" #n ")" ::: "memory")
#define PG8_BAR __builtin_amdgcn_s_barrier()
#define PG8_SCHED __builtin_amdgcn_sched_barrier(0)
    Unit cur, nxt; int ui = 0;
    if (!S.next(0, cur)) return;
    f32x4 acc[2][2][4][2];
#pragma unroll
    for (int a = 0; a < 2; ++a)
#pragma unroll
        for (int b = 0; b < 2; ++b)
#pragma unroll
            for (int m = 0; m < 4; ++m)
#pragma unroll
                for (int n = 0; n < 2; ++n) acc[a][b][m][n] = (f32x4){0.f, 0.f, 0.f, 0.f};
    bf16x8 At[4][2], B0[2][2], B1[2][2];
    const char* cA = (const char*)g.A + (size_t)cur.pm * tstep + (size_t)cur.koff * 2; const char* cB = (const char*)g.Bt + (size_t)cur.pn * tstep + (size_t)cur.koff * 2;
    S.a_ready(cur);
    if constexpr (SP2) {
        PG8_STAGE(PG8_SB(0, 0), cB, voffB); PG8_STAGE(PG8_SB(0, 1), cB + hstep, voffB); PG8_STAGE(PG8_SA(0, 0), cA, voffA); PG8_STAGE(PG8_SA(0, 1), cA + hstep, voffA);
        if (wr == 1) PG8_BAR;
        PG8_WAIT_V(2); PG8_BAR;
        PG8_STAGE(PG8_SB(1, 0), cB + kstep, voffB); PG8_STAGE(PG8_SA(1, 0), cA + kstep, voffA); PG8_STAGE(PG8_SB(1, 1), cB + hstep + kstep, voffB);
        PG8_WAIT_V(6); PG8_BAR;
    } else {
        PG8_STAGE(PG8_SB(0, 0), cB, voffB); PG8_STAGE(PG8_SA(0, 0), cA, voffA); PG8_STAGE(PG8_SB(0, 1), cB + hstep, voffB); PG8_STAGE(PG8_SA(0, 1), cA + hstep, voffA);
        if (wr == 1) PG8_BAR;
        PG8_WAIT_V(4); PG8_BAR;
        PG8_STAGE(PG8_SB(1, 0), cB + kstep, voffB); PG8_STAGE(PG8_SA(1, 0), cA + kstep, voffA); PG8_STAGE(PG8_SB(1, 1), cB + hstep + kstep, voffB);
        PG8_WAIT_V(6); PG8_BAR;
    }
    for (;;) {
        const bool has_next = S.next(ui + 1, nxt);
        const char* nA = has_next ? (const char*)g.A + (size_t)nxt.pm * tstep + (size_t)nxt.koff * 2 : cA; const char* nB = has_next ? (const char*)g.Bt + (size_t)nxt.pn * tstep + (size_t)nxt.koff * 2 : cB;
        const int nt = cur.nt;
        for (int t = 0; t < nt; t += 2) {
            const bool last = (t == nt - 2);
            const char* a1 = cA + (size_t)(t + 1) * kstep;
            const char* a2 = last ? nA : cA + (size_t)(t + 2) * kstep; const char* b2 = last ? nB : cB + (size_t)(t + 2) * kstep;
            const char* a3 = a2 + kstep; const char* b3 = b2 + kstep;
            if (last && has_next) S.a_ready(nxt);
            if constexpr (SP2) {
            PG8_LDB(B0, 0, 0); PG8_LDB(B1, 0, 1); PG8_SCHED; PG8_LDA(At, 0, 0); PG8_STAGE(PG8_SA(1, 1), a1 + hstep, voffA);
            PG8_WAIT_V(8); PG8_WAIT_L(0); PG8_BAR; PG8_MMA(0, 0, At, B0); PG8_MMA(0, 1, At, B1); PG8_BAR; PG8_SCHED;
            PG8_LDA(At, 0, 1); PG8_STAGE(PG8_SB(0, 0), b2, voffB); PG8_STAGE(PG8_SB(0, 1), b2 + hstep, voffB); PG8_STAGE(PG8_SA(0, 0), a2, voffA);
            PG8_WAIT_V(8); PG8_WAIT_L(0); PG8_BAR; PG8_MMA(1, 0, At, B0); PG8_MMA(1, 1, At, B1); PG8_BAR; PG8_SCHED;
            PG8_LDB(B0, 1, 0); PG8_LDB(B1, 1, 1); PG8_SCHED; PG8_LDA(At, 1, 0); PG8_STAGE(PG8_SA(0, 1), a2 + hstep, voffA);
            PG8_WAIT_V(8); PG8_WAIT_L(0); PG8_BAR; PG8_MMA(0, 0, At, B0); PG8_MMA(0, 1, At, B1); PG8_BAR; PG8_SCHED;
            PG8_LDA(At, 1, 1); PG8_STAGE(PG8_SB(1, 0), b3, voffB); PG8_STAGE(PG8_SB(1, 1), b3 + hstep, voffB); PG8_STAGE(PG8_SA(1, 0), a3, voffA);
            PG8_WAIT_V(8); PG8_WAIT_L(0); PG8_BAR; PG8_MMA(1, 0, At, B0); PG8_MMA(1, 1, At, B1); PG8_BAR; PG8_SCHED;
            } else {
            PG8_LDB(B0, 0, 0); PG8_SCHED; PG8_LDA(At, 0, 0); PG8_STAGE(PG8_SA(1, 1), a1 + hstep, voffA);
            PG8_WAIT_L(8); PG8_BAR; PG8_WAIT_L(0); PG8_MMA(0, 0, At, B0); PG8_BAR; PG8_SCHED;
            PG8_LDB(B1, 0, 1); PG8_STAGE(PG8_SB(0, 0), b2, voffB);
            PG8_BAR; PG8_WAIT_L(0); PG8_MMA(0, 1, At, B1); PG8_BAR;
            PG8_LDA(At, 0, 1); PG8_STAGE(PG8_SA(0, 0), a2, voffA);
            PG8_BAR; PG8_WAIT_L(0); PG8_MMA(1, 0, At, B0); PG8_BAR; PG8_SCHED;
            PG8_STAGE(PG8_SB(0, 1), b2 + hstep, voffB);
            PG8_WAIT_V(6); PG8_BAR; PG8_MMA(1, 1, At, B1); PG8_BAR;
            PG8_LDB(B0, 1, 0); PG8_SCHED; PG8_LDA(At, 1, 0); PG8_STAGE(PG8_SA(0, 1), a2 + hstep, voffA);
            PG8_WAIT_L(8); PG8_BAR; PG8_WAIT_L(0); PG8_MMA(0, 0, At, B0); PG8_BAR; PG8_SCHED;
            PG8_LDB(B1, 1, 1); PG8_STAGE(PG8_SB(1, 0), b3, voffB);
            PG8_BAR; PG8_WAIT_L(0); PG8_MMA(0, 1, At, B1); PG8_BAR;
            PG8_LDA(At, 1, 1); PG8_STAGE(PG8_SA(1, 0), a3, voffA);
            PG8_BAR; PG8_WAIT_L(0); PG8_MMA(1, 0, At, B0); PG8_BAR; PG8_SCHED;
            PG8_STAGE(PG8_SB(1, 1), b3 + hstep, voffB);
            PG8_WAIT_V(6); PG8_BAR; PG8_MMA(1, 1, At, B1); PG8_BAR;
            }
        }
        if constexpr (ALIGN_EPI) { if (wr == 0) PG8_BAR; }
        if constexpr (!Epi::AFTER_DRAIN) { E(acc, cur, wr, wc, fr, fq); S.done(cur); }
        if (!has_next) break;
#pragma unroll
        for (int a = 0; a < 2; ++a)
#pragma unroll
            for (int b = 0; b < 2; ++b)
#pragma unroll
                for (int m = 0; m < 4; ++m)
#pragma unroll
                    for (int n = 0; n < 2; ++n) acc[a][b][m][n] = (f32x4){0.f, 0.f, 0.f, 0.f};
        cur = nxt; cA = nA; cB = nB; ++ui;
        if constexpr (ALIGN_EPI) { if (wr == 1) PG8_BAR; }
    }
    PG8_WAIT_V(0);
    if constexpr (!ALIGN_EPI) { if (wr == 0) PG8_BAR; }
    PG8_BAR;
    if constexpr (Epi::AFTER_DRAIN) { E.fused(acc, cur, wr, wc, fr, fq, lds, wid, lane); S.done(cur); }
#undef PG8_SA
#undef PG8_SB
#undef PG8_STAGE
#undef PG8_LDA
#undef PG8_LDB
#undef PG8_MMA
#undef PG8_WAIT_V
#undef PG8_WAIT_L
#undef PG8_BAR
#undef PG8_SCHED
}
}
#include <hip/hip_bf16.h>
#include <cmath>
namespace attn_body {
using bf16=__hip_bfloat16;
using bf16x8=__attribute__((ext_vector_type(8)))short;
using s16x4=__attribute__((ext_vector_type(4)))short;
using f32x16=__attribute__((ext_vector_type(16)))float;
using u32x4=__attribute__((ext_vector_type(4)))unsigned;
constexpr int BATCH=2,NHEAD=16,SEQ=8192,D=64,DM=NHEAD*D;
constexpr int NW=8,QBLK=32,QB=QBLK*NW,KVBLK=64,NQB=SEQ/QB;
constexpr int ATTN_PITCH=DM, ATTN_UNIT_ROWS=QB;
__device__ __forceinline__ int crow(int r,int hi){return (r&3)+8*(r>>2)+4*hi;}
#define SBAR() __builtin_amdgcn_sched_barrier(0)
__device__ __forceinline__ void cmask(f32x16&p0,f32x16&p1,int jb,int qrel,int hi){
  const float NEG=-INFINITY; int kb=64*jb+4*hi;
  #pragma unroll
  for(int r=0;r<16;++r){int kv=kb+(r&3)+8*(r>>2); if(kv>qrel)p0[r]=NEG; if(kv+32>qrel)p1[r]=NEG;}
}

constexpr int NSLOT=3, SLOTB=8192;
constexpr int LDS_K=0, LDS_V=NSLOT*SLOTB, LDS_WS=2*NSLOT*SLOTB, LDS_OST=LDS_WS+NW*64*4, LDS_BYTES=LDS_OST+NW*4096;
constexpr float C2=0.125f*1.4426950408889634f;
__device__ __forceinline__ void glds16(const void*gsrc,unsigned lds_dst){unsigned keep;
  asm volatile("s_mov_b32 %0, m0\n\ts_mov_b32 m0, %2\n\ts_nop 0\n\tglobal_load_lds_dwordx4 %1, off\n\ts_mov_b32 m0, %0":"=&s"(keep):"v"(gsrc),"s"(lds_dst):"memory");}
__device__ __forceinline__ float max3f(float a,float b,float c){float r;asm("v_max3_f32 %0, %1, %2, %3":"=v"(r):"v"(a),"v"(b),"v"(c));return r;}
__device__ __forceinline__ float max2f(float a,float b){float r;asm("v_max_f32_e32 %0, %1, %2":"=v"(r):"v"(a),"v"(b));return r;}
__device__ __forceinline__ float fadd_s(float a,float b){float r;asm("v_add_f32_e32 %0, %1, %2":"=v"(r):"v"(a),"v"(b));return r;}
__device__ __forceinline__ float fsub_s(float a,float b){float r;asm("v_sub_f32_e32 %0, %1, %2":"=v"(r):"v"(a),"v"(b));return r;}
typedef float f32x2_t __attribute__((ext_vector_type(2))); typedef __bf16 bf16x2_t __attribute__((ext_vector_type(2)));
__device__ __forceinline__ unsigned cvtpk_s(float lo,float hi){f32x2_t v={lo,hi};bf16x2_t b=__builtin_convertvector(v,bf16x2_t);return __builtin_bit_cast(unsigned,b);}
#define WAIT_BAR(N) asm volatile("s_waitcnt vmcnt(" #N ") lgkmcnt(0)\n\ts_barrier":::"memory")

__device__ __forceinline__ void qkt(f32x16&p0,f32x16&p1,const char*Kslot,const bf16x8*qr,const f32x16&negm,int r32,int hi){
  const char*kb=Kslot+hi*1024+r32*16;
  #pragma unroll
  for(int d0=0;d0<4;++d0){
    const bf16x8 b0=*reinterpret_cast<const bf16x8*>(kb+d0*2048);
    const bf16x8 b1=*reinterpret_cast<const bf16x8*>(kb+d0*2048+512);
    if(d0==0){p0=__builtin_amdgcn_mfma_f32_32x32x16_bf16(b0,qr[0],negm,0,0,0);p1=__builtin_amdgcn_mfma_f32_32x32x16_bf16(b1,qr[0],negm,0,0,0);}
    else{p0=__builtin_amdgcn_mfma_f32_32x32x16_bf16(b0,qr[d0],p0,0,0,0);p1=__builtin_amdgcn_mfma_f32_32x32x16_bf16(b1,qr[d0],p1,0,0,0);}}
}
typedef __attribute__((address_space(3))) const char* lds_cptr;
typedef short v4i16_t __attribute__((ext_vector_type(4)));
__device__ __forceinline__ void kload8(bf16x8*kf,lds_cptr kp){
  kf[0]=*(const __attribute__((address_space(3))) bf16x8*)(kp);      kf[1]=*(const __attribute__((address_space(3))) bf16x8*)(kp+512);
  kf[2]=*(const __attribute__((address_space(3))) bf16x8*)(kp+2048); kf[3]=*(const __attribute__((address_space(3))) bf16x8*)(kp+2560);
  kf[4]=*(const __attribute__((address_space(3))) bf16x8*)(kp+4096); kf[5]=*(const __attribute__((address_space(3))) bf16x8*)(kp+4608);
  kf[6]=*(const __attribute__((address_space(3))) bf16x8*)(kp+6144); kf[7]=*(const __attribute__((address_space(3))) bf16x8*)(kp+6656);
}
__device__ __forceinline__ void kload2(bf16x8*kf,lds_cptr kp,int j){ kf[2*j]=*(const __attribute__((address_space(3))) bf16x8*)(kp+j*2048); kf[2*j+1]=*(const __attribute__((address_space(3))) bf16x8*)(kp+j*2048+512); }
__device__ __forceinline__ s16x4 vtr(lds_cptr p){ return __builtin_bit_cast(s16x4,__builtin_amdgcn_ds_read_tr16_b64_v4i16((__attribute__((address_space(3))) v4i16_t*)p)); }
__device__ __forceinline__ float rowmax(const f32x16&p0,const f32x16&p1){
  float a=max3f(p0[0],p0[1],p1[0]),b=max3f(p0[2],p0[3],p1[1]);a=max3f(a,p1[2],p1[3]);
  #pragma unroll
  for(int r=4;r<16;r+=4){a=max3f(a,p0[r],p0[r+1]);b=max3f(b,p0[r+2],p0[r+3]);a=max3f(a,p1[r],p1[r+1]);b=max3f(b,p1[r+2],p1[r+3]);}
  const float m=max2f(a,b);
  auto rr=__builtin_amdgcn_permlane32_swap(__float_as_uint(m),__float_as_uint(m),false,false);
  return max2f(__uint_as_float(rr[0]),__uint_as_float(rr[1]));
}
__device__ __forceinline__ void pv(f32x16*o,int vb,bf16x8 pa0,bf16x8 pa1,bf16x8 pa2,bf16x8 pa3){
  #pragma unroll
  for(int d0=0;d0<2;++d0){s16x4 lo[4],hi[4];
    #pragma unroll
    for(int ks=0;ks<4;++ks){
      asm volatile("ds_read_b64_tr_b16 %0,%1 offset:%c2":"=&v"(lo[ks]):"v"(vb),"i"(d0*4096+ks*1024):"memory");
      asm volatile("ds_read_b64_tr_b16 %0,%1 offset:%c2":"=&v"(hi[ks]):"v"(vb),"i"(d0*4096+ks*1024+512):"memory");}
    asm volatile("s_waitcnt lgkmcnt(0)":::"memory");SBAR();
    #define PK(k) (bf16x8){lo[k][0],lo[k][1],lo[k][2],lo[k][3],hi[k][0],hi[k][1],hi[k][2],hi[k][3]}
    o[d0]=__builtin_amdgcn_mfma_f32_32x32x16_bf16(pa0,PK(0),o[d0],0,0,0);
    o[d0]=__builtin_amdgcn_mfma_f32_32x32x16_bf16(pa1,PK(1),o[d0],0,0,0);
    o[d0]=__builtin_amdgcn_mfma_f32_32x32x16_bf16(pa2,PK(2),o[d0],0,0,0);
    o[d0]=__builtin_amdgcn_mfma_f32_32x32x16_bf16(pa3,PK(3),o[d0],0,0,0);
    #undef PK
  }
}

#ifndef ATTN_STORE16
#define ATTN_STORE16(p,v) (*(u32x4*)(p)=(v))
#endif
__device__ __forceinline__ void wmask(f32x16&p0,f32x16&p1,int t,int qrel,int hi,int q0){
  if(t<4)return;
  const float NEG=-INFINITY; const int kb=-128+64*(t-4)+4*hi;
  #pragma unroll
  for(int r=0;r<16;++r){const int kvrel=kb+(r&3)+8*(r>>2); const int d=kvrel-qrel, kv=q0+kvrel;
    const bool ok0=(d>=-128)&&(d<=128)&&(kv>=0)&&(kv<8192);
    const bool ok1=(d+32>=-128)&&(d+32<=128)&&(kv+32>=0)&&(kv+32<8192);
    if(!ok0)p0[r]=NEG; if(!ok1)p1[r]=NEG;}
}
template<int MODE,int THRL> __device__ __forceinline__ void attn_unit(const bf16*Qb,const bf16*__restrict__ Kh,const bf16*__restrict__ Vh,bf16*Ob,const int QP,const int KP,const int VP,const int OP,const int NT,const int q0,const float sinkl2,char*shm){
  int tid_=threadIdx.x; asm volatile("":"+v"(tid_)); const int tid=tid_,lane=tid&63,r32=lane&31,hi=lane>>5; const int wid=__builtin_amdgcn_readfirstlane(tid>>6);
  const bf16*Qw=Qb+(long)(wid*QBLK)*QP;
  const unsigned lds0=(unsigned)(uintptr_t)shm;
  float*wsf=(float*)(shm+LDS_WS)+wid*64;
  const bf16*ksrc=Kh+(long)lane*KP+wid*8;
  const bf16*vsrc=Vh+(long)(16*(wid&3)+(lane>>2))*VP+(wid>>2)*32+(lane&3)*8;
  const unsigned kdst=lds0+LDS_K+wid*1024, vdst=lds0+LDS_V+wid*1024;
  #define TROW(t) (64*(t)+((MODE==1&&(t)>=4)?(q0-128):0))
  #define DMA_K(t,slot) glds16(ksrc+(long)TROW(t)*KP,(unsigned)__builtin_amdgcn_readfirstlane(kdst+(slot)))
  #define DMA_V(t,slot) glds16(vsrc+(long)TROW(t)*VP,(unsigned)__builtin_amdgcn_readfirstlane(vdst+(slot)))
  const int vb0=(int)(lds0+LDS_V)+((lane>>4)&1)*32+(lane&3)*8+(4*hi+((lane&15)>>2))*64;
  const char*Kbase=shm+LDS_K; bf16x8 kf[8];
  const lds_cptr shm3=(lds_cptr)shm; const lds_cptr kp0=shm3+LDS_K+hi*1024+r32*16; const lds_cptr vp0=shm3+LDS_V+((lane>>4)&1)*32+(lane&3)*8+(4*hi+((lane&15)>>2))*64;
  DMA_K(0,0);DMA_V(0,0);DMA_K(1,SLOTB);
  bf16x8 qr[4];
  #pragma unroll
  for(int d0=0;d0<4;++d0)qr[d0]=*reinterpret_cast<const bf16x8*>(&Qw[(long)r32*QP+d0*16+hi*8]);
  float mhat=0.f,l_reg=0.f;f32x16 o[2];o[0]=f32x16{};o[1]=f32x16{};f32x16 negm=f32x16{};asm volatile("":"+v"(negm));
  const int qrel=wid*QBLK+r32;
  #define CMASK(P0,P1,t) do{ if(MODE==1) wmask(P0,P1,(t),qrel,hi,q0); }while(0)
  bool resc=false;
  #define START(P0,P1) do{ const float rm=rowmax(P0,P1); resc=false; \
    { const float dl=rm; mhat=fadd_s(mhat,dl); \
      _Pragma("unroll") for(int r=0;r<16;++r){P0[r]=fsub_s(P0[r],dl);P1[r]=fsub_s(P1[r],dl);} \
      _Pragma("unroll") for(int r=0;r<16;++r)negm[r]=-mhat; asm volatile("":"+v"(negm)); } \
    _Pragma("unroll") for(int r=0;r<16;++r)P0[r]=__builtin_amdgcn_exp2f(P0[r]); }while(0)
  #define RESC() do{ if(resc){ asm volatile("s_waitcnt lgkmcnt(0)":::"memory"); \
      _Pragma("unroll") for(int d_=0;d_<2;++d_) _Pragma("unroll") for(int r=0;r<16;++r)o[d_][r]*=wsf[crow(r,hi)]; } }while(0)
  f32x16 pA0,pA1,pB0,pB1;
  int sl_prev=0,sl_cur=0,sl_next=SLOTB;
  #define ROT() do{sl_prev=sl_cur;sl_cur=sl_next;sl_next=(sl_next==(NSLOT-1)*SLOTB)?0:sl_next+SLOTB;}while(0)
  DMA_K(2,2*SLOTB);
  WAIT_BAR(3);
  qkt(pA0,pA1,Kbase,qr,negm,r32,hi);asm volatile("s_nop 15\n\ts_nop 7":"+v"(pA0),"+v"(pA1));CMASK(pA0,pA1,0);
  START(pA0,pA1);
  _Pragma("unroll") for(int r=0;r<16;++r)pA1[r]=__builtin_amdgcn_exp2f(pA1[r]);
  WAIT_BAR(0);
  DMA_K(3,0);DMA_V(1,SLOTB);
  ROT();
  kload8(kf,kp0+sl_cur);
  WAIT_BAR(2);
  s16x4 vlo[8],vhi[8]; u32x4 pw0,pw1,pw2,pw3;
  #define PKW(P,B) cvtpk_s(P[B],P[B+1])
  #define PAF(k) __builtin_bit_cast(bf16x8,pw##k)
  #define VFR(i) (bf16x8){vlo[i][0],vlo[i][1],vlo[i][2],vlo[i][3],vhi[i][0],vhi[i][1],vhi[i][2],vhi[i][3]}
  #define PIN(x) asm volatile("":"+v"(x))
  #define MX3(a,b,c) __builtin_fmaxf(__builtin_fmaxf((a),(b)),(c))
  #define GAPA(MF,A0,A1,A2,A3,W0,W1,PW) do{ MF; sacc+=A0; sacc+=A1; sacc+=A2; sacc+=A3; PIN(sacc); W0; W1; PIN(PW); SBAR(); }while(0)
  #define EX(v) __builtin_amdgcn_exp2f(v)
  #define GAPB(MF,X,B) do{ MF; X[B]=EX(X[B]); X[B+1]=EX(X[B+1]); X[B+2]=EX(X[B+2]); X[B+3]=EX(X[B+3]); PIN(X); SBAR(); }while(0)
  #define VRD(i) do{ vlo[i]=vtr(vp_+(((i)>>2)*4096+((i)&3)*1024)); vhi[i]=vtr(vp_+(((i)>>2)*4096+((i)&3)*1024+512)); }while(0)
  #define KRD(G,j) do{ if(G){ kload2(kf,kp0+sl_next,j); SBAR(); } }while(0)
  #define STEP(C0,C1,P0,P1,t,GK,GV,GL) do{ SBAR(); \
    const lds_cptr vp_=vp0+sl_prev; \
    VRD(0); SBAR(); float sacc=(P0[0]+P0[1]); \
    GAPA(C0=__builtin_amdgcn_mfma_f32_32x32x16_bf16(kf[0],qr[0],negm,0,0,0), P0[2],P0[3],P0[4],P0[5],     pw0[0]=PKW(P0,0), pw0[1]=PKW(P0,2), pw0); \
    VRD(4); SBAR(); GAPA(C1=__builtin_amdgcn_mfma_f32_32x32x16_bf16(kf[1],qr[0],negm,0,0,0), P0[6],P0[7],P0[8],P0[9],     pw0[2]=PKW(P0,4), pw0[3]=PKW(P0,6), pw0); \
    VRD(1); SBAR(); GAPA(C0=__builtin_amdgcn_mfma_f32_32x32x16_bf16(kf[2],qr[1],C0,0,0,0),   P0[10],P0[11],P0[12],P0[13], pw1[0]=PKW(P0,8), pw1[1]=PKW(P0,10), pw1); \
    VRD(5); SBAR(); GAPA(C1=__builtin_amdgcn_mfma_f32_32x32x16_bf16(kf[3],qr[1],C1,0,0,0),   P0[14],P0[15],P1[0],P1[1],   pw1[2]=PKW(P0,12),pw1[3]=PKW(P0,14), pw1); \
    VRD(2); SBAR(); GAPA(C0=__builtin_amdgcn_mfma_f32_32x32x16_bf16(kf[4],qr[2],C0,0,0,0),   P1[2],P1[3],P1[4],P1[5],     pw2[0]=PKW(P1,0), pw2[1]=PKW(P1,2), pw2); \
    VRD(6); SBAR(); GAPA(C1=__builtin_amdgcn_mfma_f32_32x32x16_bf16(kf[5],qr[2],C1,0,0,0),   P1[6],P1[7],P1[8],P1[9],     pw2[2]=PKW(P1,4), pw2[3]=PKW(P1,6), pw2); \
    VRD(3); SBAR(); GAPA(C0=__builtin_amdgcn_mfma_f32_32x32x16_bf16(kf[6],qr[3],C0,0,0,0),   P1[10],P1[11],P1[12],P1[13], pw3[0]=PKW(P1,8), pw3[1]=PKW(P1,10), pw3); \
    VRD(7); SBAR(); GAPA(C1=__builtin_amdgcn_mfma_f32_32x32x16_bf16(kf[7],qr[3],C1,0,0,0),   P1[14],P1[15],0.f,0.f,       pw3[2]=PKW(P1,12),pw3[3]=PKW(P1,14), pw3); \
    l_reg+=sacc; \
    if(GK){DMA_K((t)+3,sl_cur);} if(GV){DMA_V((t)+1,sl_next);} \
    CMASK(C0,C1,t); \
    { float a=MX3(C0[0],C0[1],C1[0]),b=MX3(C0[2],C0[3],C1[1]); a=MX3(a,C1[2],C1[3]); \
      _Pragma("unroll") for(int r=4;r<16;r+=4){a=MX3(a,C0[r],C0[r+1]);b=MX3(b,C0[r+2],C0[r+3]);a=MX3(a,C1[r],C1[r+1]);b=MX3(b,C1[r+2],C1[r+3]);} \
      float rm=__builtin_fmaxf(a,b); { auto rr=__builtin_amdgcn_permlane32_swap(__float_as_uint(rm),__float_as_uint(rm),false,false); rm=__builtin_fmaxf(__uint_as_float(rr[0]),__uint_as_float(rr[1])); } \
      resc=false; \
      if(__builtin_expect(__any(rm>(float)THRL),0)){ const float dl=__builtin_fmaxf(rm,0.f); mhat+=dl; \
        _Pragma("unroll") for(int r=0;r<16;++r){C0[r]-=dl;C1[r]-=dl;} \
        _Pragma("unroll") for(int r=0;r<16;++r)negm[r]=-mhat; asm volatile("":"+v"(negm)); \
        const float f=__builtin_amdgcn_exp2f(-dl); l_reg*=f; if(hi==0)wsf[r32]=f; resc=true; } } \
    SBAR(); \
    GAPB(o[0]=__builtin_amdgcn_mfma_f32_32x32x16_bf16(PAF(0),VFR(0),o[0],0,0,0), C0,0); \
    GAPB(o[1]=__builtin_amdgcn_mfma_f32_32x32x16_bf16(PAF(0),VFR(4),o[1],0,0,0), C0,4); \
    KRD(GL,0); GAPB(o[0]=__builtin_amdgcn_mfma_f32_32x32x16_bf16(PAF(1),VFR(1),o[0],0,0,0), C0,8); \
    KRD(GL,1); GAPB(o[1]=__builtin_amdgcn_mfma_f32_32x32x16_bf16(PAF(1),VFR(5),o[1],0,0,0), C0,12); \
    KRD(GL,2); GAPB(o[0]=__builtin_amdgcn_mfma_f32_32x32x16_bf16(PAF(2),VFR(2),o[0],0,0,0), C1,0); \
    KRD(GL,3); GAPB(o[1]=__builtin_amdgcn_mfma_f32_32x32x16_bf16(PAF(2),VFR(6),o[1],0,0,0), C1,4); \
    GAPB(o[0]=__builtin_amdgcn_mfma_f32_32x32x16_bf16(PAF(3),VFR(3),o[0],0,0,0), C1,8); \
    GAPB(o[1]=__builtin_amdgcn_mfma_f32_32x32x16_bf16(PAF(3),VFR(7),o[1],0,0,0), C1,12); \
    }while(0)
  int t=1;
  for(;t+5<NT;t+=2){
    STEP(pB0,pB1,pA0,pA1,t,true,true,true);     WAIT_BAR(2); RESC(); ROT();
    STEP(pA0,pA1,pB0,pB1,t+1,true,true,true);   WAIT_BAR(2); RESC(); ROT();
  }
  #define ENDW(tt) do{ if((tt)+3<NT){WAIT_BAR(2);} else if((tt)+2<NT){WAIT_BAR(1);} else {WAIT_BAR(0);} }while(0)
  for(;t+1<NT;t+=2){
    STEP(pB0,pB1,pA0,pA1,t,(t+3<NT),(t+1<NT),(t+1<NT));       ENDW(t);   RESC(); ROT();
    STEP(pA0,pA1,pB0,pB1,t+1,(t+4<NT),(t+2<NT),(t+2<NT));     ENDW(t+1); RESC(); ROT();
  }
  STEP(pB0,pB1,pA0,pA1,NT-1,false,false,false); RESC();
  { float sacc=pB0[0]+pB0[1]; _Pragma("unroll") for(int r=2;r<16;++r)sacc+=pB0[r]; _Pragma("unroll") for(int r=0;r<16;++r)sacc+=pB1[r]; l_reg+=sacc;
    pw0=(u32x4){PKW(pB0,0),PKW(pB0,2),PKW(pB0,4),PKW(pB0,6)};pw1=(u32x4){PKW(pB0,8),PKW(pB0,10),PKW(pB0,12),PKW(pB0,14)};pw2=(u32x4){PKW(pB1,0),PKW(pB1,2),PKW(pB1,4),PKW(pB1,6)};pw3=(u32x4){PKW(pB1,8),PKW(pB1,10),PKW(pB1,12),PKW(pB1,14)};
    SBAR(); pv(o,vb0+sl_cur,PAF(0),PAF(1),PAF(2),PAF(3)); }
  #undef PKW
  #undef PAF
  #undef VFR
  #undef PIN
  #undef MX3
  #undef GAPA
  #undef GAPB
  #undef EX
  #undef VRD
  #undef KRD
  #undef STEP
  #undef ENDW
  {auto rr=__builtin_amdgcn_permlane32_swap(__float_as_uint(l_reg),__float_as_uint(l_reg),false,false);l_reg=__uint_as_float(rr[0])+__uint_as_float(rr[1]);}
  l_reg+=__builtin_amdgcn_exp2f(sinkl2-mhat);
  if(hi==0)wsf[32+r32]=l_reg;asm volatile("s_waitcnt lgkmcnt(0)":::"memory");
  float rli[16];
  #pragma unroll
  for(int r=0;r<16;++r)rli[r]=__builtin_amdgcn_rcpf(wsf[32+crow(r,hi)]);
  bf16*Ow=Ob+(long)(wid*QBLK)*OP;
  { bf16*stg=(bf16*)(shm+LDS_OST)+wid*2048;
    #pragma unroll
    for(int r=0;r<16;++r){const int orow=crow(r,hi);
      #pragma unroll
      for(int d0=0;d0<2;++d0)stg[orow*64+d0*32+r32]=__float2bfloat16(o[d0][r]*rli[r]);}
    asm volatile("s_waitcnt lgkmcnt(0)":::"memory");
    #pragma unroll
    for(int i=0;i<4;++i){const int row=i*8+(lane>>3),ch=lane&7; const u32x4 v=*(const u32x4*)(stg+row*64+ch*8); ATTN_STORE16(Ow+(long)row*OP+ch*8,v);} }
  asm volatile("s_waitcnt lgkmcnt(0)\n\ts_barrier":::"memory");
  #undef DMA_K
  #undef TROW
  #undef DMA_V
  #undef CMASK
  #undef START
  #undef RESC
  #undef ROT
}
template<int THRL> __device__ __forceinline__ void attn_unit128(const bf16*Qb,const bf16*__restrict__ Kh,const bf16*__restrict__ Vh,bf16*Ob,const int QP,const int KP,const int VP,const int OP,const int NT,char*shm){
  int tid_=threadIdx.x; asm volatile("":"+v"(tid_)); const int tid=tid_,lane=tid&63,r32=lane&31,hi=lane>>5; const int wid=__builtin_amdgcn_readfirstlane(tid>>6);
  constexpr int L_K=0, L_V=3*8192, L_WS=L_V+3*16384, L_OST=L_WS+NW*64*4;
  const bf16*Qw=Qb+(long)(wid*QBLK)*QP;
  const unsigned lds0=(unsigned)(uintptr_t)shm;
  float*wsf=(float*)(shm+L_WS)+wid*64;
  const bf16*ksrc=Kh+(long)lane*KP+wid*8;
  const bf16*vsrc=Vh+(long)(16*(wid&3)+(lane>>2))*VP+(wid>>2)*32+(lane&3)*8;
  const unsigned kdst=lds0+L_K+wid*1024, vdst=lds0+L_V+wid*1024;
  #define DK(t,slot) glds16(ksrc+(long)(64*(t))*KP,(unsigned)__builtin_amdgcn_readfirstlane(kdst+(slot)))
  #define DV(t,slot) do{ glds16(vsrc+(long)(64*(t))*VP,(unsigned)__builtin_amdgcn_readfirstlane(vdst+2*(slot))); glds16(vsrc+(long)(64*(t))*VP+64,(unsigned)__builtin_amdgcn_readfirstlane(vdst+2*(slot)+8192)); }while(0)
  const lds_cptr shm3=(lds_cptr)shm; const lds_cptr kp0=shm3+L_K+hi*1024+r32*16; const lds_cptr vp0=shm3+L_V+((lane>>4)&1)*32+(lane&3)*8+(4*hi+((lane&15)>>2))*64;
  bf16x8 kf[8];
  DK(0,0);DV(0,0);DK(1,SLOTB);
  bf16x8 qr[4];
  #pragma unroll
  for(int d0=0;d0<4;++d0)qr[d0]=*reinterpret_cast<const bf16x8*>(&Qw[(long)r32*QP+d0*16+hi*8]);
  float mhat=0.f,l_reg=0.f;f32x16 o[4];o[0]=f32x16{};o[1]=f32x16{};o[2]=f32x16{};o[3]=f32x16{};f32x16 negm=f32x16{};asm volatile("":"+v"(negm));
  bool resc=false;
  int sl_prev=0,sl_cur=0,sl_next=SLOTB;
  #define ROT() do{sl_prev=sl_cur;sl_cur=sl_next;sl_next=(sl_next==(NSLOT-1)*SLOTB)?0:sl_next+SLOTB;}while(0)
  #define RESC4() do{ if(resc){ asm volatile("s_waitcnt lgkmcnt(0)":::"memory"); \
      _Pragma("unroll") for(int r=0;r<16;++r){ const float f_=wsf[crow(r,hi)]; o[0][r]*=f_; o[1][r]*=f_; o[2][r]*=f_; o[3][r]*=f_; } } }while(0)
  #define MX3(a,b,c) __builtin_fmaxf(__builtin_fmaxf((a),(b)),(c))
  #define PKW(P,B) cvtpk_s(P[B],P[B+1])
  #define PAF(k) __builtin_bit_cast(bf16x8,pw##k)
  #define FRG(lo,hi_) (bf16x8){lo[0],lo[1],lo[2],lo[3],hi_[0],hi_[1],hi_[2],hi_[3]}
  #define ROWMAX(rm) do{ float a=MX3(c0[0],c0[1],c1[0]),b=MX3(c0[2],c0[3],c1[1]); a=MX3(a,c1[2],c1[3]); \
      _Pragma("unroll") for(int r=4;r<16;r+=4){a=MX3(a,c0[r],c0[r+1]);b=MX3(b,c0[r+2],c0[r+3]);a=MX3(a,c1[r],c1[r+1]);b=MX3(b,c1[r+2],c1[r+3]);} \
      rm=__builtin_fmaxf(a,b); { auto rr=__builtin_amdgcn_permlane32_swap(__float_as_uint(rm),__float_as_uint(rm),false,false); rm=__builtin_fmaxf(__uint_as_float(rr[0]),__uint_as_float(rr[1])); } }while(0)
  #define POST() do{ float s_=(c0[0]+c0[1]); _Pragma("unroll") for(int r=2;r<16;++r)s_+=c0[r]; _Pragma("unroll") for(int r=0;r<16;++r)s_+=c1[r]; l_reg+=s_; \
      pw0=(u32x4){PKW(c0,0),PKW(c0,2),PKW(c0,4),PKW(c0,6)};pw1=(u32x4){PKW(c0,8),PKW(c0,10),PKW(c0,12),PKW(c0,14)};pw2=(u32x4){PKW(c1,0),PKW(c1,2),PKW(c1,4),PKW(c1,6)};pw3=(u32x4){PKW(c1,8),PKW(c1,10),PKW(c1,12),PKW(c1,14)}; }while(0)
  u32x4 pw0,pw1,pw2,pw3; f32x16 c0,c1;
  DK(2,2*SLOTB);
  WAIT_BAR(4);
  qkt(c0,c1,shm+L_K,qr,negm,r32,hi);
  { float rm; ROWMAX(rm); mhat=rm;
    #pragma unroll
    for(int r=0;r<16;++r){c0[r]=__builtin_amdgcn_exp2f(c0[r]-rm);c1[r]=__builtin_amdgcn_exp2f(c1[r]-rm);}
    #pragma unroll
    for(int r=0;r<16;++r)negm[r]=-mhat;
    asm volatile("":"+v"(negm)); }
  POST();
  WAIT_BAR(0);
  DK(3,0);DV(1,SLOTB);
  ROT();
  kload8(kf,kp0+sl_cur);
  WAIT_BAR(3);
  const bool late_=(wid>=4);
  for(int t=1;t<NT;++t){
    const bool GK=(t+3<NT), GV=(t+1<NT);
    const lds_cptr vp_=vp0+2*sl_prev;
    s16x4 vlo[8],vhi[8];
    #pragma unroll
    for(int i=0;i<8;++i){ const int fi=(i>>1)+4*(i&1);
      vlo[fi]=vtr(vp_+((fi>>2)*4096+(fi&3)*1024)); vhi[fi]=vtr(vp_+((fi>>2)*4096+(fi&3)*1024+512));
      if((i&1)==0){ if(i==0)c0=__builtin_amdgcn_mfma_f32_32x32x16_bf16(kf[0],qr[0],negm,0,0,0); else c0=__builtin_amdgcn_mfma_f32_32x32x16_bf16(kf[i],qr[i>>1],c0,0,0,0); }
      else        { if(i==1)c1=__builtin_amdgcn_mfma_f32_32x32x16_bf16(kf[1],qr[0],negm,0,0,0); else c1=__builtin_amdgcn_mfma_f32_32x32x16_bf16(kf[i],qr[i>>1],c1,0,0,0); } }
    if(GK){DK(t+3,sl_cur);} if(GV){DV(t+1,sl_next);}
    { float rm; ROWMAX(rm); resc=false;
      if(__builtin_expect(__any(rm>(float)THRL),0)){ const float dl=__builtin_fmaxf(rm,0.f); mhat+=dl;
        #pragma unroll
        for(int r=0;r<16;++r){c0[r]-=dl;c1[r]-=dl;}
        #pragma unroll
        for(int r=0;r<16;++r)negm[r]=-mhat;
        asm volatile("":"+v"(negm));
        const float f=__builtin_amdgcn_exp2f(-dl); l_reg*=f; if(hi==0)wsf[r32]=f; resc=true; } }
    SBAR();
    s16x4 wlo[8],whi[8];
    #pragma unroll
    for(int i=0;i<8;++i){ const int fi=(i>>1)+4*(i&1), ks=i>>1;
      if(GV){ if(i>=3&&i<=6) kload2(kf,kp0+sl_next,i-3); }
      const bf16x8 pa=(ks==0)?PAF(0):(ks==1)?PAF(1):(ks==2)?PAF(2):PAF(3);
      if((i&1)==0) o[0]=__builtin_amdgcn_mfma_f32_32x32x16_bf16(pa,FRG(vlo[fi],vhi[fi]),o[0],0,0,0);
      else         o[1]=__builtin_amdgcn_mfma_f32_32x32x16_bf16(pa,FRG(vlo[fi],vhi[fi]),o[1],0,0,0);
      wlo[fi]=vtr(vp_+(8192+(fi>>2)*4096+(fi&3)*1024)); whi[fi]=vtr(vp_+(8192+(fi>>2)*4096+(fi&3)*1024+512));
      c0[2*i]=__builtin_amdgcn_exp2f(c0[2*i]); c0[2*i+1]=__builtin_amdgcn_exp2f(c0[2*i+1]);
      SBAR(); }
    #define PHASE_B2() do{ float s2_=0.f; \
    _Pragma("unroll") \
    for(int i=0;i<8;++i){ const int fi=(i>>1)+4*(i&1), ks=i>>1; \
    const bf16x8 pa=(ks==0)?PAF(0):(ks==1)?PAF(1):(ks==2)?PAF(2):PAF(3); \
    if((i&1)==0) o[2]=__builtin_amdgcn_mfma_f32_32x32x16_bf16(pa,FRG(wlo[fi],whi[fi]),o[2],0,0,0); \
    else         o[3]=__builtin_amdgcn_mfma_f32_32x32x16_bf16(pa,FRG(wlo[fi],whi[fi]),o[3],0,0,0); \
    c1[2*i]=__builtin_amdgcn_exp2f(c1[2*i]); c1[2*i+1]=__builtin_amdgcn_exp2f(c1[2*i+1]); \
    s2_+=c0[2*i]; s2_+=c0[2*i+1]; \
    if(i==1) pw0=(u32x4){PKW(c0,0),PKW(c0,2),PKW(c0,4),PKW(c0,6)}; \
    if(i==3) pw1=(u32x4){PKW(c0,8),PKW(c0,10),PKW(c0,12),PKW(c0,14)}; \
    if(i==5) pw2=(u32x4){PKW(c1,0),PKW(c1,2),PKW(c1,4),PKW(c1,6)}; \
    SBAR(); } \
    pw3=(u32x4){PKW(c1,8),PKW(c1,10),PKW(c1,12),PKW(c1,14)}; \
    _Pragma("unroll") for(int r=0;r<16;++r)s2_+=c1[r]; \
    l_reg+=s2_; \
    }while(0)
    if(!late_){ PHASE_B2(); }
    if(t+1<NT){
      if(t+3<NT){WAIT_BAR(3);} else if(t+2<NT){WAIT_BAR(2);} else {WAIT_BAR(0);}
      if(late_){ PHASE_B2(); }
      RESC4(); ROT();
    } else { if(late_){ PHASE_B2(); } RESC4(); }
  }
  { const lds_cptr vp_=vp0+2*sl_cur;
    #pragma unroll
    for(int d0=0;d0<4;++d0){ s16x4 lo[4],hi4[4];
      #pragma unroll
      for(int ks=0;ks<4;++ks){ lo[ks]=vtr(vp_+(d0*4096+ks*1024)); hi4[ks]=vtr(vp_+(d0*4096+ks*1024+512)); }
      o[d0]=__builtin_amdgcn_mfma_f32_32x32x16_bf16(PAF(0),FRG(lo[0],hi4[0]),o[d0],0,0,0);
      o[d0]=__builtin_amdgcn_mfma_f32_32x32x16_bf16(PAF(1),FRG(lo[1],hi4[1]),o[d0],0,0,0);
      o[d0]=__builtin_amdgcn_mfma_f32_32x32x16_bf16(PAF(2),FRG(lo[2],hi4[2]),o[d0],0,0,0);
      o[d0]=__builtin_amdgcn_mfma_f32_32x32x16_bf16(PAF(3),FRG(lo[3],hi4[3]),o[d0],0,0,0); } }
  {auto rr=__builtin_amdgcn_permlane32_swap(__float_as_uint(l_reg),__float_as_uint(l_reg),false,false);l_reg=__uint_as_float(rr[0])+__uint_as_float(rr[1]);}
  if(hi==0)wsf[32+r32]=l_reg;asm volatile("s_waitcnt lgkmcnt(0)":::"memory");
  float rli[16];
  #pragma unroll
  for(int r=0;r<16;++r)rli[r]=__builtin_amdgcn_rcpf(wsf[32+crow(r,hi)]);
  int lane2=threadIdx.x&63; asm volatile("":"+v"(lane2));
  const int lane_e=lane2, r32e=lane2&31, hie=lane2>>5;
  bf16*Ow=Ob+(long)(wid*QBLK)*OP;
  bf16*stg=(bf16*)(shm+L_OST)+wid*2048;
  #pragma unroll
  for(int ps=0;ps<2;++ps){
    #pragma unroll
    for(int r=0;r<16;++r){const int orow=crow(r,hie);
      #pragma unroll
      for(int d0=0;d0<2;++d0)stg[orow*64+d0*32+r32e]=__float2bfloat16(o[2*ps+d0][r]*rli[r]);}
    asm volatile("s_waitcnt lgkmcnt(0)":::"memory");
    #pragma unroll
    for(int i=0;i<4;++i){const int row=i*8+(lane_e>>3),ch=lane_e&7; const u32x4 v=*(const u32x4*)(stg+row*64+ch*8); ATTN_STORE16(Ow+(long)row*OP+ps*64+ch*8,v);}
    asm volatile("s_waitcnt lgkmcnt(0)":::"memory");
  }
  asm volatile("s_waitcnt lgkmcnt(0)\n\ts_barrier":::"memory");
  #undef DK
  #undef DV
  #undef ROT
  #undef RESC4
  #undef MX3
  #undef PKW
  #undef PAF
  #undef FRG
  #undef ROWMAX
  #undef POST
  #undef PHASE_B2
}
#undef SBAR
#undef WAIT_BAR
}
constexpr int NWAVES = 8;
constexpr int NB = 4, SEQ = 8192, DM = 1024, CTXL = 256, DFF = 2816, DEPTH = 4;
constexpr int ML = NB * SEQ, MC = NB * CTXL, MT = ML + MC;
constexpr int KVB = CTXL + SEQ;
constexpr float EPS = 1e-6f;
constexpr size_t MiB = 1u << 20;
constexpr size_t WS_BAR = 64 * 1024;
constexpr size_t WS_ROPE = 0;
constexpr size_t WS_MOD = 1 * MiB;
constexpr size_t WS_CTXX = 2 * MiB;
constexpr size_t WS_WIN = 8 * MiB;
constexpr size_t WS_WOUT = 96 * MiB;
constexpr size_t WS_WO = 140 * MiB;
constexpr size_t WS_WQKV = 148 * MiB;
constexpr size_t WS_H = 164 * MiB;
constexpr size_t WS_HID = 230 * MiB;
constexpr size_t WS_Q = 230 * MiB;
constexpr size_t WS_K = 296 * MiB;
constexpr size_t WS_V = 363 * MiB;
constexpr size_t WS_O = 430 * MiB;
constexpr size_t WS_PART = 562 * MiB;
constexpr size_t WS_SS = 606 * MiB;
constexpr size_t WS_BIAS2 = 608 * MiB;
constexpr size_t WS_END = 610 * MiB;
constexpr int B2_LAYER = 71680, B2_QKV = 28160, B2_S1 = 43520;
constexpr int LDS_BYTES = 147456;

#define GAS __attribute__((address_space(1)))
#define LAS __attribute__((address_space(3)))
typedef unsigned short bf16;
typedef unsigned v4u __attribute__((ext_vector_type(4)));
typedef float f32x4 __attribute__((ext_vector_type(4)));
#define LDS_WAIT() asm volatile("s_waitcnt lgkmcnt(0)" ::: "memory")
__device__ __forceinline__ unsigned f2bf(float f) { unsigned u = __builtin_bit_cast(unsigned, f); return (u + 0x7fffu + ((u >> 16) & 1u)) >> 16; }
__device__ __forceinline__ unsigned pk2(float lo, float hi) { return f2bf(lo) | (f2bf(hi) << 16); }
__device__ __forceinline__ float bf2f(unsigned short h) { return __builtin_bit_cast(float, (unsigned)h << 16); }
__device__ __forceinline__ float wave_sum(float v) {
#pragma unroll
    for (int o = 1; o < 64; o <<= 1) v += __shfl_xor(v, o);
    return v;
}
__device__ __forceinline__ void transpose_item(const float* W, int K, int N, bf16* WT, int mode, LAS float* scr, int item, int lane) {
    const int nblk = N / 32, kb = item / nblk, nb = item % nblk, k0 = 64 * kb, n0 = 32 * nb;
    int drow = n0;
    if (mode == 1) { const int isu = n0 >= DFF ? 1 : 0; const int j = n0 - isu * DFF; drow = 256 * (j / 128) + isu * 128 + (j % 128); }
    else if (mode == 2) { const int pn = n0 / 256, cn = n0 % 256; drow = 256 * pn + 128 * ((cn % 64) / 32) + 32 * (cn / 64); }
    float tv[32];
#pragma unroll
    for (int i = 0; i < 32; ++i) tv[i] = __builtin_nontemporal_load(W + (size_t)(k0 + 2 * i + (lane >> 5)) * N + n0 + (lane & 31));
#pragma unroll
    for (int i = 0; i < 32; ++i) scr[(2 * i + (lane >> 5)) * 33 + (lane & 31)] = tv[i];
    LDS_WAIT(); asm volatile("" ::: "memory");
    const int c = lane & 7;
#pragma unroll
    for (int j = 0; j < 4; ++j) { const int n = (lane >> 3) + 8 * j; const LAS float* s = scr + (8 * c) * 33 + n;
        v4u o; o.x = pk2(s[0 * 33], s[1 * 33]); o.y = pk2(s[2 * 33], s[3 * 33]); o.z = pk2(s[4 * 33], s[5 * 33]); o.w = pk2(s[6 * 33], s[7 * 33]);
        *(GAS v4u*)(WT + (size_t)(drow + n) * K + k0 + 8 * c) = o; }
    LDS_WAIT(); asm volatile("" ::: "memory");
}

#define XB_TMO      128
#define XB_XCNT(j)  (256  + 64 * (j))
#define XB_XSUB(j)  (1280 + 64 * (j))
#define XB_XGEN(j)  (2304 + 64 * (j))
#define XB_TOP      3328
#define XB_TOPGEN   3392
#define XCD_BAR_WORDS 3456
#define XB_SPIN_CAP (1u << 18)

__device__ __forceinline__ unsigned xb_ld(unsigned* p)              { return __hip_atomic_load(p, __ATOMIC_RELAXED, __HIP_MEMORY_SCOPE_AGENT); }
__device__ __forceinline__ unsigned xb_add(unsigned* p, unsigned v) { return __hip_atomic_fetch_add(p, v, __ATOMIC_RELAXED, __HIP_MEMORY_SCOPE_AGENT); }
__device__ __forceinline__ unsigned xb_xcc_id() { return (unsigned)__builtin_amdgcn_s_getreg((3 << 11) | 20) & 0xFu; }
#define XB_SPIN(cond, bar) do { unsigned _sp = 0; while (cond) { __builtin_amdgcn_s_sleep(1); \
    if ((++_sp & 255u) == 0u) { if (xb_ld(&(bar)[XB_TMO])) break; if (_sp > XB_SPIN_CAP) { atomicAdd(&(bar)[XB_TMO], 1u); break; } } } } while (0)

struct XcdBarrier {
    unsigned* bar; unsigned x;
    volatile LAS unsigned* st;
};

__device__ __forceinline__ XcdBarrier xcd_barrier_post(unsigned* bar, volatile LAS unsigned* st) {
    XcdBarrier b; b.bar = bar; b.x = xb_xcc_id(); b.st = st;
    if (threadIdx.x == 0) (void)xb_add(&bar[XB_XCNT(b.x)], 1u);
    return b;
}
__device__ __forceinline__ void xcd_barrier_complete(unsigned* bar, unsigned x, unsigned& nloc, unsigned& nx) {
    const unsigned G = gridDim.x * gridDim.y * gridDim.z;
    unsigned sum, cnt, mine, sp = 0u;
    for (;;) {
        sum = 0u; cnt = 0u; mine = 0u;
#pragma unroll
        for (unsigned j = 0; j < 16; ++j) { const unsigned c = xb_ld(&bar[XB_XCNT(j)]); sum += c; cnt += (c > 0u) ? 1u : 0u; mine = (j == x) ? c : mine; }
        if (sum == G) break;
        __builtin_amdgcn_s_sleep(1);
        if ((++sp & 255u) == 0u) { if (xb_ld(&bar[XB_TMO])) break; if (sp > XB_SPIN_CAP) { atomicAdd(&bar[XB_TMO], 1u); break; } }
    }
    nloc = mine > 0u ? mine : 1u; nx = cnt > 0u ? cnt : 1u;
}

__device__ __forceinline__ void xcd_barrier(const XcdBarrier& b) {
    asm volatile("s_waitcnt vmcnt(0)" ::: "memory");
    __syncthreads();
    if (threadIdx.x == 0) {
        unsigned* bar = b.bar;
        __builtin_amdgcn_s_waitcnt(0);
        unsigned nloc = b.st[0], nx = b.st[1];
        if (nloc == 0u) { xcd_barrier_complete(bar, b.x, nloc, nx); b.st[0] = nloc; b.st[1] = nx; }
        const unsigned old = xb_add(&bar[XB_XSUB(b.x)], 1u);
        const unsigned gen = old / nloc;
        if (old + 1u == (gen + 1u) * nloc) {
            __builtin_amdgcn_fence(__ATOMIC_RELEASE, "agent");
            asm volatile("s_waitcnt vmcnt(0)" ::: "memory");
            const unsigned og = xb_add(&bar[XB_TOP], 1u);
            const unsigned tg = og / nx;
            if (og + 1u == (tg + 1u) * nx) xb_add(&bar[XB_TOPGEN], 1u);
            else XB_SPIN(xb_ld(&bar[XB_TOPGEN]) == tg, bar);
            __builtin_amdgcn_fence(__ATOMIC_ACQUIRE, "agent");
            xb_add(&bar[XB_XGEN(b.x)], 1u);
            asm volatile("s_waitcnt vmcnt(0)" ::: "memory");
        } else {
            XB_SPIN(xb_ld(&bar[XB_XGEN(b.x)]) == gen, bar);
            __builtin_amdgcn_fence(__ATOMIC_ACQUIRE, "agent");
            asm volatile("s_waitcnt vmcnt(0)" ::: "memory");
        }
    }
    __syncthreads();
}

struct Args {
    const float *x, *c, *ctx, *c_ctx, *norm_g, *w_ada, *b_ada, *w_ffn_in, *w_ffn_out, *w_o, *w_qkv_a, *qk_norm_a, *w_qkv_b, *qk_norm_b, *sink_b, *w_qkv_c, *qk_norm_c, *diff_lambda, *diff_subln;
    float* out; unsigned char* ws;
    float inv_freq[16];
};

__global__ void __launch_bounds__(NWAVES * 64, 2) dit_fwd(Args A) {
    extern __shared__ __attribute__((aligned(16))) unsigned char lds[];
    cg::grid_group grid = cg::this_grid();
    LAS unsigned char* ldsL = (LAS unsigned char*)lds;
    const int tid = threadIdx.x, lane = tid & 63, wave = __builtin_amdgcn_readfirstlane(tid >> 6);
    const int G = gridDim.x, bx = blockIdx.x;
    const int vcu = (G % 8 == 0) ? (bx % 8) * (G / 8) + bx / 8 : bx;
    const int gw = vcu * NWAVES + wave, NGW = G * NWAVES;

    volatile LAS unsigned* MISC = (volatile LAS unsigned*)(ldsL + 131072 + 320);
    if (tid < 32) MISC[tid] = 0u;
    if (bx == 0) { for (int w = tid; w < XCD_BAR_WORDS; w += NWAVES * 64) __hip_atomic_store((unsigned*)(A.ws + WS_BAR) + w, 0u, __ATOMIC_RELAXED, __HIP_MEMORY_SCOPE_AGENT); }
    { f32x4* z = (f32x4*)(A.ws + WS_SS); for (int w = bx * NWAVES * 64 + tid; w < 12 * MT / 4; w += G * NWAVES * 64) z[w] = (f32x4){0.f, 0.f, 0.f, 0.f}; }
    {
        unsigned char* ws = A.ws;
        float* ROPE = (float*)(ws + WS_ROPE); float* MOD = (float*)(ws + WS_MOD);
        bf16 *WIN = (bf16*)(ws + WS_WIN), *WOUT = (bf16*)(ws + WS_WOUT), *WO = (bf16*)(ws + WS_WO), *WQKV = (bf16*)(ws + WS_WQKV);
        LAS float* sv = (LAS float*)(ldsL + 69632);
        LAS float* part = (LAS float*)(ldsL + 90112);
        for (int idx = tid; idx < 5 * 1024; idx += NWAVES * 64) { const int j = idx >> 10, k = idx & 1023; const float v = (j < 4) ? A.c[j * 1024 + k] : A.c_ctx[k]; sv[idx] = v / (1.0f + __expf(-v)); }
        __syncthreads();
        for (int it = bx; it < 4 * 144; it += G) {
            const int layer = it / 144, cgp = it % 144;
            const float* W = A.w_ada + (size_t)layer * 1024 * 9216 + cgp * 64 + lane;
            float a0 = 0.f, a1 = 0.f, a2 = 0.f, a3 = 0.f, a4 = 0.f;
#pragma unroll 32
            for (int kk = 0; kk < 128; ++kk) { const int k = wave * 128 + kk; const float w = W[(size_t)k * 9216];
                a0 += sv[k] * w; a1 += sv[1024 + k] * w; a2 += sv[2048 + k] * w; a3 += sv[3072 + k] * w; a4 += sv[4096 + k] * w; }
            part[(wave * 5 + 0) * 64 + lane] = a0; part[(wave * 5 + 1) * 64 + lane] = a1; part[(wave * 5 + 2) * 64 + lane] = a2; part[(wave * 5 + 3) * 64 + lane] = a3; part[(wave * 5 + 4) * 64 + lane] = a4;
            __syncthreads();
            if (tid < 320) { const int j = tid >> 6, l = tid & 63; float s = A.b_ada[layer * 9216 + cgp * 64 + l];
#pragma unroll
                for (int w = 0; w < 8; ++w) s += part[(w * 5 + j) * 64 + l];
                MOD[(size_t)(layer * 5 + j) * 9216 + cgp * 64 + l] = s; }
            __syncthreads();
        }
        { const int idx = bx * NWAVES * 64 + tid;
          if (idx < 2048) { const int p = idx >> 4, f = idx & 15; const float ang = (float)p * A.inv_freq[f];
              double rev = (double)ang * 0.15915494309189535; rev -= rint(rev); const float r = (float)(rev * 6.283185307179586);
              ROPE[idx] = __cosf(r); ROPE[2048 + idx] = __sinf(r); } }
        LAS float* scr = (LAS float*)(ldsL + wave * 8448);
        constexpr int I_IN = 16 * 176, I_OUT = 44 * 32, I_O = 16 * 32, I_QA = 16 * 48, I_QC = 16 * 96;
        constexpr int NITEMS = 8 * I_IN + 8 * I_OUT + 4 * I_O + 3 * I_QA + I_QC;
        for (int it = gw; it < NITEMS; it += NGW) {
            int r = it;
            if (r < 8 * I_IN) { const int mi = r / I_IN; transpose_item(A.w_ffn_in + (size_t)mi * 1024 * 5632, 1024, 5632, WIN + (size_t)mi * 5632 * 1024, 1, scr, r % I_IN, lane); continue; } r -= 8 * I_IN;
            if (r < 8 * I_OUT) { const int mi = r / I_OUT; transpose_item(A.w_ffn_out + (size_t)mi * 2816 * 1024, 2816, 1024, WOUT + (size_t)mi * 1024 * 2816, 0, scr, r % I_OUT, lane); continue; } r -= 8 * I_OUT;
            if (r < 4 * I_O) { const int mi = r / I_O; transpose_item(A.w_o + (size_t)mi * 1024 * 1024, 1024, 1024, WO + (size_t)mi * 1024 * 1024, 0, scr, r % I_O, lane); continue; } r -= 4 * I_O;
            if (r < I_QA) { transpose_item(A.w_qkv_a, 1024, 1536, WQKV, 2, scr, r, lane); continue; } r -= I_QA;
            if (r < I_QA) { transpose_item(A.w_qkv_b, 1024, 1536, WQKV + (size_t)1536 * 1024, 2, scr, r, lane); continue; } r -= I_QA;
            if (r < I_QC) { transpose_item(A.w_qkv_c, 1024, 3072, WQKV + (size_t)3072 * 1024, 2, scr, r, lane); continue; } r -= I_QC;
            transpose_item(A.w_qkv_a + (size_t)1024 * 1536, 1024, 1536, WQKV + (size_t)6144 * 1024, 2, scr, r, lane);
        }
    }
    grid.sync();
    const XcdBarrier xbar = xcd_barrier_post((unsigned*)(A.ws + WS_BAR), MISC + 8);

    for (int ph = 0; ph < DEPTH * 11; ++ph) {
        const int i = ph / 11, s = ph % 11, kind = i % 3; const bool last = (i == DEPTH - 1);
        int tidp = threadIdx.x; asm volatile("" : "+v"(tidp));
        const int lane = tidp & 63;
        GAS unsigned char* wsg = (GAS unsigned char*)A.ws; asm volatile("" : "+s"(wsg)); unsigned char* ws = (unsigned char*)wsg;
        float* ROPE = (float*)(ws + WS_ROPE); float* MOD = (float*)(ws + WS_MOD); float* CTXX = (float*)(ws + WS_CTXX);
        bf16 *WIN = (bf16*)(ws + WS_WIN), *WOUT = (bf16*)(ws + WS_WOUT), *WO = (bf16*)(ws + WS_WO), *WQKV = (bf16*)(ws + WS_WQKV);
        bf16 *HB = (bf16*)(ws + WS_H), *HID = (bf16*)(ws + WS_HID), *QB = (bf16*)(ws + WS_Q), *KB = (bf16*)(ws + WS_K), *VB = (bf16*)(ws + WS_V), *OB = (bf16*)(ws + WS_O);
        const int Mi = (last && s >= 6) ? ML : MT;
        const float* modL = MOD + (size_t)i * 5 * 9216;
        const float* xinL = (i == 0 && s < 3) ? A.x : A.out; const float* xinC = (i == 0 && s <= 3) ? A.ctx : CTXX;
        float* SSB = (float*)(ws + WS_SS); float* B2 = (float*)(ws + WS_BIAS2) + (size_t)i * B2_LAYER;
        if (s == 0 || s == 3 || s == 8) {
            if (last && s == 8) continue;
            const int k = (s == 0) ? 0 : (s == 3 ? 1 : 2);
            const bool full = (i == 0 && s == 0);
            float* SSq = SSB + (size_t)(i * 3 + k) * MT;
            const GAS f32x4* g4 = (const GAS f32x4*)(A.norm_g + (size_t)(i * 3 + k) * 1024) + lane;
            const int pnk = (s == 0) ? (i > 0 ? 11 : 0) : (s == 3 ? 11 : 4);
            const float pcoef = (s == 8) ? 1.0f : 0.5f;
            const GAS f32x4* pg4 = (const GAS f32x4*)(MOD + (size_t)((s == 0 ? i - 1 : i) * 5 + 4) * 9216 + (s == 0 ? 8 : (s == 3 ? 2 : 5)) * 1024) + lane;
            const GAS f32x4* pp4 = (const GAS f32x4*)(ws + WS_PART) + lane;
            if (full) {
                f32x4 vnx[4];
                { const GAS f32x4* xr0 = (const GAS f32x4*)(gw < ML ? xinL + (size_t)gw * 1024 : xinC + (size_t)(gw - ML) * 1024) + lane;
#pragma unroll
                  for (int j = 0; j < 4; ++j) vnx[j] = xr0[64 * j]; }
                for (int m = gw; m < MT; m += NGW) {
                    const int slot = m < ML ? (m >> 13) : 4;
                    const GAS f32x4* sc4 = (const GAS f32x4*)(modL + slot * 9216 + (3 * k + 1) * 1024) + lane;
                    f32x4 v[4]; float ss = 0.f;
#pragma unroll
                    for (int j = 0; j < 4; ++j) v[j] = vnx[j];
                    { const int mn = m + NGW; if (mn < MT) { const GAS f32x4* xrn = (const GAS f32x4*)(mn < ML ? xinL + (size_t)mn * 1024 : xinC + (size_t)(mn - ML) * 1024) + lane;
#pragma unroll
                        for (int j = 0; j < 4; ++j) vnx[j] = xrn[64 * j]; } }
#pragma unroll
                    for (int j = 0; j < 4; ++j) ss += (v[j].x * v[j].x + v[j].y * v[j].y) + (v[j].z * v[j].z + v[j].w * v[j].w);
                    ss = wave_sum(ss);
                    if (lane == 0) SSq[m] = ss;
                    GAS unsigned long long* o8 = (GAS unsigned long long*)(HB + (size_t)m * 1024) + lane;
#pragma unroll
                    for (int j = 0; j < 4; ++j) { const f32x4 gg = g4[64 * j], sc = sc4[64 * j];
                        const f32x4 y = v[j] * gg * (sc + 1.0f);
                        o8[64 * j] = (unsigned long long)pk2(y.x, y.y) | ((unsigned long long)pk2(y.z, y.w) << 32); }
                }
            }
            for (int m = (full ? MT : ML) + gw; m < MT; m += NGW) {
                const float* xrow = m < ML ? xinL + (size_t)m * 1024 : xinC + (size_t)(m - ML) * 1024;
                const int slot = m < ML ? (m >> 13) : 4;
                const GAS f32x4* sc4 = (const GAS f32x4*)(modL + slot * 9216 + (3 * k + 1) * 1024) + lane;
                const GAS f32x4* xr = (const GAS f32x4*)xrow + lane;
                f32x4 v[4]; float ss = 0.f;
#pragma unroll
                for (int j = 0; j < 4; ++j) v[j] = xr[64 * j];
                if (m >= ML && pnk > 0) {
                    GAS f32x4* xo = (GAS f32x4*)(CTXX + (size_t)(m - ML) * 1024) + lane;
#pragma unroll
                    for (int j = 0; j < 4; ++j) { f32x4 pa[11];
#pragma unroll
                        for (int kc = 0; kc < 11; ++kc) pa[kc] = pp4[(size_t)(kc < pnk ? kc : 0) * 262144 + (size_t)(m - ML) * 256 + 64 * j];
                        f32x4 a = pa[0];
#pragma unroll
                        for (int kc = 1; kc < 11; ++kc) if (kc < pnk) a += pa[kc];
                        v[j] += a * pg4[64 * j] * pcoef; xo[64 * j] = v[j]; }
                }
#pragma unroll
                for (int j = 0; j < 4; ++j) ss += (v[j].x * v[j].x + v[j].y * v[j].y) + (v[j].z * v[j].z + v[j].w * v[j].w);
                ss = wave_sum(ss);
                if (lane == 0) SSq[m] = ss;
                GAS unsigned long long* o8 = (GAS unsigned long long*)(HB + (size_t)m * 1024) + lane;
#pragma unroll
                for (int j = 0; j < 4; ++j) { const f32x4 gg = g4[64 * j], sc = sc4[64 * j];
                    const f32x4 y = v[j] * gg * (sc + 1.0f);
                    o8[64 * j] = (unsigned long long)pk2(y.x, y.y) | ((unsigned long long)pk2(y.z, y.w) << 32); }
            }
            if (full) {
                float* B2all = (float*)(ws + WS_BIAS2);
                constexpr int B2_ROWS = 3 * 12800 + 14336, B2_CHUNK = (B2_ROWS + 2047) / 2048;
                int r = gw * B2_CHUNK; const int rend = (r + B2_CHUNK < B2_ROWS) ? r + B2_CHUNK : B2_ROWS;
                while (r < rend) {
                    const int layer = r < 12800 ? 0 : (r < 25600 ? 1 : (r < 39936 ? 2 : 3)); const int lbase = layer == 0 ? 0 : (layer == 1 ? 12800 : (layer == 2 ? 25600 : 39936));
                    const int Nq = (layer == 2) ? 3072 : 1536; const int rl = r - lbase;
                    const int kk = rl < 5632 ? 0 : (rl < 5632 + Nq ? 1 : 2); const int kbase = kk == 0 ? 0 : (kk == 1 ? 5632 : 5632 + Nq);
                    const int N = (kk == 1) ? Nq : 5632; const int off = kk == 0 ? 0 : (kk == 1 ? B2_QKV : B2_S1);
                    const bf16* Wt = kk == 1 ? WQKV + (size_t)(layer == 0 ? 0 : (layer == 1 ? 1536 : (layer == 2 ? 3072 : 6144))) * 1024 : WIN + (size_t)(layer * 2 + (kk == 2 ? 1 : 0)) * 5632 * 1024;
                    int n = rl - kbase; const int nseg = ((lbase + kbase + N) < rend ? (lbase + kbase + N) : rend) - r;
                    f32x4 shv[5][4];
#pragma unroll
                    for (int slot = 0; slot < 5; ++slot) { const f32x4* sh = (const f32x4*)(MOD + (size_t)(layer * 5 + slot) * 9216 + (3 * kk) * 1024 + lane * 16);
#pragma unroll
                        for (int q4 = 0; q4 < 4; ++q4) shv[slot][q4] = sh[q4]; }
                    for (int j = 0; j < nseg; j += 2) {
                        const bool two = (j + 1 < nseg);
                        const v4u* wpa = (const v4u*)(Wt + (size_t)(n + j) * 1024 + lane * 16); const v4u* wpb = (const v4u*)(Wt + (size_t)(n + j + (two ? 1 : 0)) * 1024 + lane * 16);
                        const v4u a0 = wpa[0], a1 = wpa[1], b0 = wpb[0], b1 = wpb[1];
                        const unsigned wa[8] = {a0.x, a0.y, a0.z, a0.w, a1.x, a1.y, a1.z, a1.w}, wb[8] = {b0.x, b0.y, b0.z, b0.w, b1.x, b1.y, b1.z, b1.w};
                        float da[5], db[5];
#pragma unroll
                        for (int slot = 0; slot < 5; ++slot) { float sa = 0.f, sb = 0.f;
#pragma unroll
                            for (int e = 0; e < 8; ++e) { const float t0 = shv[slot][e >> 1][(e & 1) * 2], t1 = shv[slot][e >> 1][(e & 1) * 2 + 1];
                                sa += t0 * bf2f((unsigned short)(wa[e] & 0xffffu)) + t1 * bf2f((unsigned short)(wa[e] >> 16));
                                sb += t0 * bf2f((unsigned short)(wb[e] & 0xffffu)) + t1 * bf2f((unsigned short)(wb[e] >> 16)); }
                            da[slot] = sa; db[slot] = sb; }
#pragma unroll
                        for (int o = 1; o < 64; o <<= 1) {
#pragma unroll
                            for (int slot = 0; slot < 5; ++slot) { da[slot] += __shfl_xor(da[slot], o); db[slot] += __shfl_xor(db[slot], o); } }
                        if (lane < 5) { const float va = lane == 0 ? da[0] : (lane == 1 ? da[1] : (lane == 2 ? da[2] : (lane == 3 ? da[3] : da[4])));
                            const float vb = lane == 0 ? db[0] : (lane == 1 ? db[1] : (lane == 2 ? db[2] : (lane == 3 ? db[3] : db[4])));
                            float* dst = B2all + (size_t)layer * B2_LAYER + off + lane * N + n + j;
                            dst[0] = va; if (two) dst[1] = vb; }
                    }
                    r += nseg;
                }
            }
        } else if (s == 1 || s == 9) {
            pg8::Gemm g{HB, WIN + (size_t)(i * 2 + (s == 9 ? 1 : 0)) * 5632 * 1024, Mi, 5632, 1024}; pg8::StaticOrder S; S.init(Mi, 5632, G, bx); S.ntf = 16;
            pg8::EpiSwiglu E{HID, DFF, SSB + (size_t)(i * 3 + (s == 9 ? 2 : 0)) * MT, B2 + (s == 9 ? B2_S1 : 0)};
            pg8::gemm_phase<pg8::EpiSwiglu, pg8::StaticOrder, true, true>(ldsL, g, S, E);
        } else if (s == 2 || s == 7 || s == 10) {
            const int k = (s == 2) ? 0 : (s == 7 ? 1 : 2);
            const bf16* Am = (s == 7) ? ((kind == 2) ? QB : OB) : HID;
            const bf16* Wm = (s == 7) ? WO + (size_t)i * 1024 * 1024 : WOUT + (size_t)(i * 2 + (s == 10 ? 1 : 0)) * 1024 * 2816;
            const int Kd = (s == 7) ? 1024 : 2816;
            pg8::Gemm g{Am, Wm, Mi, 1024, Kd}; pg8::ResidOrder S; S.base.init(ML, 1024, G, bx); S.base.ntf = Kd / 64; S.nkc = (Mi == MT) ? Kd / 256 : 0;
            const int qn = i * 3 + k + 1;
            const bool emit = qn < 3 * DEPTH;
            const int qq = emit ? qn : 0;
            pg8::EpiResid E{xinL, A.out, (float*)(ws + WS_PART), modL + (3 * k + 2) * 1024,
                            A.norm_g + (size_t)qq * 1024, MOD + (size_t)(qq / 3) * 5 * 9216 + (3 * (qq % 3) + 1) * 1024, HB, SSB + (size_t)qq * MT, (s == 7) ? 1.0f : 0.5f, emit ? 1 : 0};
            pg8::gemm_phase<pg8::EpiResid, pg8::ResidOrder, true, true>(ldsL, g, S, E);
        } else if (s == 4) {
            const int N = (kind == 2) ? 3072 : 1536;
            const bf16* Wm = WQKV + (size_t)(i == 0 ? 0 : (i == 1 ? 1536 : (i == 2 ? 3072 : 6144))) * 1024;
            const float* gqk = (kind == 0) ? A.qk_norm_a + (i / 3) * 128 : (kind == 1 ? A.qk_norm_b : A.qk_norm_c);
            pg8::Gemm g{HB, Wm, Mi, N, 1024}; pg8::StaticOrder S; S.init(Mi, N, G, bx); S.ntf = 16;
            pg8::EpiQKV E{QB, KB, VB, (kind == 2) ? 4 : 1, (kind == 2) ? 1024 : 256, gqk, ROPE, attn_body::C2, SSB + (size_t)(i * 3 + 1) * MT, B2 + B2_QKV, N};
            pg8::gemm_phase<pg8::EpiQKV, pg8::StaticOrder, true, true>(ldsL, g, S, E);
        } else if (s == 5) {
            using attn_body::attn_unit;
            typedef const attn_body::bf16* cbp; typedef attn_body::bf16* bp;
            const float NINF = -INFINITY;
            if (kind == 1) {
                for (int u = vcu; u < NB * 16 * 32; u += G) { const int qb = u & 31, h = (u >> 5) & 15, b = u >> 9;
                    const size_t qoff = (size_t)(b * SEQ + qb * 256) * 1024 + h * 64, kvoff = (size_t)b * KVB * 256 + (h >> 2) * 64;
                    attn_unit<1, 8>((cbp)QB + qoff, (cbp)KB + kvoff, (cbp)VB + kvoff, (bp)OB + qoff, 1024, 256, 256, 1024, 12, qb * 256, A.sink_b[h] * 1.4426950408889634f, (char*)lds); }
            }
            const int n0 = (kind == 0) ? NB * 16 * 32 : 0;
            const int nctx = (last || kind == 2) ? 0 : NB * 16;
            for (int u = vcu; u < n0 + nctx; u += G) {
                int h, b, row, nt; float sk = NINF;
                if (u < n0) { const int qb = u & 31; h = (u >> 5) & 15; b = u >> 9; row = b * SEQ + qb * 256; nt = (KVB / 64); }
                else { const int uc = u - n0; h = uc & 15; b = uc >> 4; row = ML + b * CTXL; nt = CTXL / 64; if (kind == 1) sk = A.sink_b[h] * 1.4426950408889634f; }
                const size_t qoff = (size_t)row * 1024 + h * 64, koff = (size_t)b * KVB * 256 + (h >> 2) * 64;
                attn_unit<0, 8>((cbp)QB + qoff, (cbp)KB + koff, (cbp)VB + koff, (bp)OB + qoff, 1024, 256, 256, 1024, nt, 0, sk, (char*)lds);
            }
            if (kind == 2) {
                const int n2 = NB * 8 * 2 * 32, nc2 = last ? 0 : NB * 8 * 2;
                for (int u = vcu; u < n2 + nc2; u += G) {
                    int mp, h8, b, row, nt;
                    if (u < n2) { const int qb = u & 31; mp = (u >> 5) & 1; h8 = (u >> 6) & 7; b = u >> 9; row = b * SEQ + qb * 256; nt = (KVB / 64); }
                    else { const int uc = u - n2; mp = uc & 1; h8 = (uc >> 1) & 7; b = uc >> 4; row = ML + b * CTXL; nt = CTXL / 64; }
                    const size_t qoff = (size_t)row * 1024 + h8 * 128 + mp * 64, koff = (size_t)b * KVB * 1024 + h8 * 128 + mp * 64, voff = (size_t)b * KVB * 1024 + h8 * 128;
                    const size_t ooff = (size_t)row * 2048 + mp * 1024 + h8 * 128;
                    attn_body::attn_unit128<8>((cbp)QB + qoff, (cbp)KB + koff, (cbp)VB + voff, (bp)OB + ooff, 1024, 1024, 1024, 2048, nt, (char*)lds);
                }
            }
        } else {
            if (kind != 2) continue;
            const float lam_init = 0.8f - 0.6f * expf(-0.3f * (float)i);
            const float* lp = A.diff_lambda + (size_t)(i / 3) * 256;
            const float lam = expf(wave_sum(lp[lane] * lp[64 + lane])) - expf(wave_sum(lp[128 + lane] * lp[192 + lane])) + lam_init;
            const float* sg = A.diff_subln + (size_t)(i / 3) * 128 + (lane & 7) * 16;
            float gsub[16];
#pragma unroll
            for (int e = 0; e < 16; ++e) gsub[e] = sg[e] * (1.0f - lam_init);
            for (int m = gw; m < Mi; m += NGW) {
                const v4u* p1 = (const v4u*)(OB + (size_t)m * 2048 + lane * 16); const v4u* p2 = (const v4u*)(OB + (size_t)m * 2048 + 1024 + lane * 16);
                const v4u a0 = p1[0], a1 = p1[1], b0 = p2[0], b1 = p2[1];
                const unsigned aw[8] = {a0.x, a0.y, a0.z, a0.w, a1.x, a1.y, a1.z, a1.w}, bw[8] = {b0.x, b0.y, b0.z, b0.w, b1.x, b1.y, b1.z, b1.w};
                float o[16]; float ss = 0.f;
#pragma unroll
                for (int e = 0; e < 8; ++e) { o[2 * e] = bf2f((unsigned short)(aw[e] & 0xffffu)) - lam * bf2f((unsigned short)(bw[e] & 0xffffu));
                    o[2 * e + 1] = bf2f((unsigned short)(aw[e] >> 16)) - lam * bf2f((unsigned short)(bw[e] >> 16)); ss += o[2 * e] * o[2 * e] + o[2 * e + 1] * o[2 * e + 1]; }
                ss += __shfl_xor(ss, 1); ss += __shfl_xor(ss, 2); ss += __shfl_xor(ss, 4);
                const float rstd = 1.0f / sqrtf(ss * (1.0f / 128.0f) + EPS);
                v4u w0, w1;
                w0.x = pk2(o[0] * rstd * gsub[0], o[1] * rstd * gsub[1]); w0.y = pk2(o[2] * rstd * gsub[2], o[3] * rstd * gsub[3]); w0.z = pk2(o[4] * rstd * gsub[4], o[5] * rstd * gsub[5]); w0.w = pk2(o[6] * rstd * gsub[6], o[7] * rstd * gsub[7]);
                w1.x = pk2(o[8] * rstd * gsub[8], o[9] * rstd * gsub[9]); w1.y = pk2(o[10] * rstd * gsub[10], o[11] * rstd * gsub[11]); w1.z = pk2(o[12] * rstd * gsub[12], o[13] * rstd * gsub[13]); w1.w = pk2(o[14] * rstd * gsub[14], o[15] * rstd * gsub[15]);
                v4u* po = (v4u*)(QB + (size_t)m * 1024 + lane * 16); po[0] = w0; po[1] = w1;
            }
        }
        if (ph + 1 < DEPTH * 11) xcd_barrier(xbar);
    }
}

extern "C" void kernel_launch(void* const* d_in, const int* in_sizes, int n_in, void* d_out, int out_size, void* d_ws, size_t ws_size, hipStream_t stream) {
    static int grid = 0;
    if (grid == 0) {
        if (n_in != 19 || out_size != ML * DM || ws_size < WS_END) { fprintf(stderr, "kernel_launch: unexpected problem (n_in %d, out %d, ws %zu; need ws >= %zu)\n", n_in, out_size, ws_size, (size_t)WS_END); grid = -1; return; }
        int dev = 0, cus = 0, per_cu = 0;
        if (hipGetDevice(&dev) != hipSuccess || hipDeviceGetAttribute(&cus, hipDeviceAttributeMultiprocessorCount, dev) != hipSuccess) { grid = -1; return; }
        if (hipFuncSetAttribute((const void*)dit_fwd, hipFuncAttributeMaxDynamicSharedMemorySize, LDS_BYTES) != hipSuccess) { fprintf(stderr, "kernel_launch: hipFuncSetAttribute failed\n"); grid = -1; return; }
        if (hipOccupancyMaxActiveBlocksPerMultiprocessor(&per_cu, (const void*)dit_fwd, NWAVES * 64, LDS_BYTES) != hipSuccess || per_cu < 1) { fprintf(stderr, "kernel_launch: occupancy query says %d blocks/CU\n", per_cu); per_cu = 1; }
        (void)hipGetLastError();
        grid = cus;
    }
    if (grid < 0) return;
    Args a{};
    a.x = (const float*)d_in[0]; a.c = (const float*)d_in[1]; a.ctx = (const float*)d_in[2]; a.c_ctx = (const float*)d_in[3]; a.norm_g = (const float*)d_in[4];
    a.w_ada = (const float*)d_in[5]; a.b_ada = (const float*)d_in[6]; a.w_ffn_in = (const float*)d_in[7]; a.w_ffn_out = (const float*)d_in[8]; a.w_o = (const float*)d_in[9];
    a.w_qkv_a = (const float*)d_in[10]; a.qk_norm_a = (const float*)d_in[11]; a.w_qkv_b = (const float*)d_in[12]; a.qk_norm_b = (const float*)d_in[13]; a.sink_b = (const float*)d_in[14];
    a.w_qkv_c = (const float*)d_in[15]; a.qk_norm_c = (const float*)d_in[16]; a.diff_lambda = (const float*)d_in[17]; a.diff_subln = (const float*)d_in[18];
    a.out = (float*)d_out; a.ws = (unsigned char*)d_ws;
    for (int f = 0; f < 16; ++f) a.inv_freq[f] = powf(10000.0f, -(float)f / 16.0f);
    void* args[] = {&a};
    hipError_t e = hipLaunchCooperativeKernel((const void*)dit_fwd, dim3(grid), dim3(NWAVES * 64), args, LDS_BYTES, stream);
    if (e != hipSuccess) fprintf(stderr, "kernel_launch: cooperative launch failed: %s (grid %d)\n", hipGetErrorString(e), grid);
}
```
